# Optimizing an MI355X kernel written in HIP

```python
import jax, jax.numpy as jnp
from jax import lax
import numpy as np

D_MODEL = 1024
BATCH = 8
SEQ = 2048
DEPTH = 1

MEM_LEN = 256
D_MIX = D_MODEL
GLA_WIDTH = D_MIX // 2
GLA_HEADS = 4
GLA_DV = GLA_WIDTH // GLA_HEADS
GLA_DK = GLA_DV // 2
GLA_KEY_WIDTH = GLA_HEADS * GLA_DK
GATE_RANK = 16
GATE_TAU = 16.0
CHUNK = 64
CONV_WIDTH = D_MIX - GLA_WIDTH
CONV_KERNEL = 31
IN_SIZES = (GLA_KEY_WIDTH, GLA_KEY_WIDTH, GLA_WIDTH, GLA_WIDTH, GATE_RANK, GATE_RANK, 2 * CONV_WIDTH)
IN_WIDTH = sum(IN_SIZES)
XATTN_HEADS = 4
XATTN_DH = D_MODEL // XATTN_HEADS
N_EXPERTS = 32
TOP_K = 4
D_FF_EXPERT = D_MODEL
SWIGLU_ALPHA = 1.702
SWIGLU_LIMIT = 7.0
MOE_BLOCK = 128
RMS_EPS = 1e-6
LN_EPS = 1e-5

kernel_name = "hybrid_gla_conformer_moe_encoder"


def rms_norm(x, g):
    xf = x.astype(jnp.float32)
    y = xf * lax.rsqrt(jnp.mean(xf * xf, axis=-1, keepdims=True) + RMS_EPS)
    return (y * g.astype(jnp.float32)).astype(x.dtype)


def layer_norm(x, g, b):
    xf = x.astype(jnp.float32)
    mu = jnp.mean(xf, axis=-1, keepdims=True)
    var = jnp.mean(jnp.square(xf - mu), axis=-1, keepdims=True)
    y = (xf - mu) * lax.rsqrt(var + LN_EPS)
    return (y * g.astype(jnp.float32) + b.astype(jnp.float32)).astype(x.dtype)


def gla_direction(q, k, v, log_a, strict):
    B, H, S, dk = q.shape
    dv = v.shape[-1]
    n = S // CHUNK
    qc = q.astype(jnp.float32).reshape(B, H, n, CHUNK, dk)
    kc = k.astype(jnp.float32).reshape(B, H, n, CHUNK, dk)
    vc = v.astype(jnp.float32).reshape(B, H, n, CHUNK, dv)
    bcum = jnp.cumsum(log_a.astype(jnp.float32).reshape(B, H, n, CHUNK, dk), axis=-2)
    b_last = bcum[..., -1:, :]
    idx = jnp.arange(CHUNK)
    mask = (idx[:, None] > idx[None, :]) if strict else (idx[:, None] >= idx[None, :])
    diff = bcum[..., :, None, :] - bcum[..., None, :, :]
    decay = jnp.exp(jnp.where(mask[:, :, None], diff, -jnp.inf))
    scores = jnp.einsum('bhnid,bhnjd,bhnijd->bhnij', qc, kc, decay)
    o_intra = jnp.einsum('bhnij,bhnjv->bhniv', scores, vc)
    u = jnp.einsum('bhncd,bhncv->bhndv', kc * jnp.exp(b_last - bcum), vc)
    a_chunk = jnp.exp(b_last[..., 0, :])

    def step(state, inp):
        a, uc = inp
        return a[..., None] * state + uc, state

    init = jnp.zeros((B, H, dk, dv), jnp.float32)
    _, s_in = lax.scan(step, init, (jnp.moveaxis(a_chunk, 2, 0), jnp.moveaxis(u, 2, 0)))
    s_in = jnp.moveaxis(s_in, 0, 2)
    o_inter = jnp.einsum('bhncd,bhndv->bhncv', qc * jnp.exp(bcum), s_in)
    return (o_intra + o_inter).reshape(B, H, S, dv)


def gla_group(q, k, v, r, gf, gb, w2_f, b_f, w2_b, b_b, norm_g):
    B, S, _ = q.shape

    def heads(t, d):
        return t.reshape(B, S, GLA_HEADS, d).transpose(0, 2, 1, 3)

    qh = heads(q, GLA_DK) * (GLA_DK ** -0.5)
    kh = heads(k, GLA_DK)
    vh = heads(v, GLA_DV)
    la_f = heads(jax.nn.log_sigmoid((gf @ w2_f + b_f).astype(jnp.float32)) / GATE_TAU, GLA_DK)
    la_b = heads(jax.nn.log_sigmoid((gb @ w2_b + b_b).astype(jnp.float32)) / GATE_TAU, GLA_DK)
    flip = lambda t: t[:, :, ::-1]
    o_f = gla_direction(qh, kh, vh, la_f, strict=False)
    o_b = flip(gla_direction(flip(qh), flip(kh), flip(vh), flip(la_b), strict=True))
    o = rms_norm(o_f + o_b, norm_g)
    o = o.transpose(0, 2, 1, 3).reshape(B, S, GLA_WIDTH)
    return (o * jax.nn.silu(r.astype(jnp.float32))).astype(q.dtype)


def conv_group(glu_in, conv_w, conv_b, ln_g, ln_b):
    a, g = jnp.split(glu_in, 2, axis=-1)
    u = a * jax.nn.sigmoid(g)
    pad = (CONV_KERNEL - 1) // 2
    y = lax.conv_general_dilated(
        u, conv_w[:, None, :].astype(u.dtype), window_strides=(1,), padding=[(pad, pad)],
        dimension_numbers=('NWC', 'WIO', 'NWC'), feature_group_count=CONV_WIDTH) + conv_b
    return jax.nn.silu(layer_norm(y, ln_g, ln_b))


def memory_cross_attention(h, m, wq, wk, wv, wo):
    B, S, _ = h.shape
    M = m.shape[1]
    q = (h @ wq).reshape(B, S, XATTN_HEADS, XATTN_DH)
    k = (m @ wk).reshape(B, M, XATTN_HEADS, XATTN_DH)
    v = (m @ wv).reshape(B, M, XATTN_HEADS, XATTN_DH)
    s = jnp.einsum('bqhd,bkhd->bhqk', q, k).astype(jnp.float32) * (XATTN_DH ** -0.5)
    p = jax.nn.softmax(s, axis=-1).astype(v.dtype)
    o = jnp.einsum('bhqk,bkhd->bqhd', p, v).reshape(B, S, D_MODEL)
    return o @ wo


def moe_ffn(h, router_w, router_b, w_up, b_up, w_down, b_down):
    B, S, D = h.shape
    T = B * S
    ht = h.reshape(T, D)
    logits = (ht @ router_w + router_b).astype(jnp.float32)
    top_vals, top_idx = lax.top_k(logits, TOP_K)
    gates = jax.nn.softmax(top_vals, axis=-1)
    A = T * TOP_K
    flat_e = top_idx.reshape(A)
    flat_tok = jnp.arange(A, dtype=jnp.int32) // TOP_K
    order = jnp.argsort(flat_e, stable=True)
    sorted_e = flat_e[order]
    sorted_tok = flat_tok[order]
    counts = jnp.bincount(flat_e, length=N_EXPERTS)
    padded = ((counts + MOE_BLOCK - 1) // MOE_BLOCK) * MOE_BLOCK
    starts = jnp.cumsum(counts) - counts
    pends = jnp.cumsum(padded)
    pstarts = pends - padded
    rank = jnp.arange(A, dtype=jnp.int32) - starts[sorted_e]
    dest = pstarts[sorted_e] + rank
    n_blocks = (A + N_EXPERTS * (MOE_BLOCK - 1) + MOE_BLOCK - 1) // MOE_BLOCK
    n_rows = n_blocks * MOE_BLOCK
    xs = jnp.zeros((n_rows, D), ht.dtype).at[dest].set(ht[sorted_tok])
    block_start = jnp.arange(n_blocks, dtype=pends.dtype) * MOE_BLOCK
    block_e = jnp.clip(jnp.searchsorted(pends, block_start, side='right'), 0, N_EXPERTS - 1)

    def expert_block(args):
        xb, e = args
        gu = xb @ w_up[e] + b_up[e]
        x_glu = jnp.minimum(gu[:, :D_FF_EXPERT], SWIGLU_LIMIT)
        x_lin = jnp.clip(gu[:, D_FF_EXPERT:], -SWIGLU_LIMIT, SWIGLU_LIMIT)
        hid = x_glu * jax.nn.sigmoid(SWIGLU_ALPHA * x_glu) * (x_lin + 1)
        return hid @ w_down[e] + b_down[e]

    ys = lax.map(expert_block, (xs.reshape(n_blocks, MOE_BLOCK, D), block_e)).reshape(n_rows, D)
    w_sorted = gates.reshape(A)[order].astype(ys.dtype)
    out = jax.ops.segment_sum(ys[dest] * w_sorted[:, None], sorted_tok, num_segments=T)
    return out.reshape(B, S, D).astype(h.dtype)


def setup_inputs(seed: int = 0) -> dict:
    key = jax.random.key(seed)
    ks = jax.random.split(key, 32)
    f32 = jnp.float32
    nrm = lambda k, shape, s: jax.random.normal(k, shape, f32) * s
    L = DEPTH
    return {
        "x": nrm(ks[0], (BATCH, SEQ, D_MODEL), 1.0),
        "mem": nrm(ks[1], (BATCH, MEM_LEN, D_MODEL), 1.0),
        "norm_mix_g": 1.0 + nrm(ks[2], (L, D_MODEL), 0.02),
        "w_in": nrm(ks[3], (L, D_MODEL, IN_WIDTH), D_MODEL ** -0.5),
        "gate_w2_fwd": nrm(ks[4], (L, GATE_RANK, GLA_KEY_WIDTH), GATE_RANK ** -0.5),
        "gate_b_fwd": nrm(ks[5], (L, GLA_KEY_WIDTH), 0.1),
        "gate_w2_bwd": nrm(ks[6], (L, GATE_RANK, GLA_KEY_WIDTH), GATE_RANK ** -0.5),
        "gate_b_bwd": nrm(ks[7], (L, GLA_KEY_WIDTH), 0.1),
        "gla_norm_g": 1.0 + nrm(ks[8], (L, GLA_DV), 0.02),
        "conv_w": nrm(ks[9], (L, CONV_KERNEL, CONV_WIDTH), CONV_KERNEL ** -0.5),
        "conv_b": nrm(ks[10], (L, CONV_WIDTH), 0.02),
        "conv_ln_g": 1.0 + nrm(ks[11], (L, CONV_WIDTH), 0.02),
        "conv_ln_b": nrm(ks[12], (L, CONV_WIDTH), 0.02),
        "w_out": nrm(ks[13], (L, D_MIX, D_MODEL), D_MIX ** -0.5),
        "norm_xattn_g": 1.0 + nrm(ks[14], (L, D_MODEL), 0.02),
        "norm_mem_g": 1.0 + nrm(ks[15], (L, D_MODEL), 0.02),
        "xattn_wq": nrm(ks[16], (L, D_MODEL, D_MODEL), D_MODEL ** -0.5),
        "xattn_wk": nrm(ks[17], (L, D_MODEL, D_MODEL), D_MODEL ** -0.5),
        "xattn_wv": nrm(ks[18], (L, D_MODEL, D_MODEL), D_MODEL ** -0.5),
        "xattn_wo": nrm(ks[19], (L, D_MODEL, D_MODEL), D_MODEL ** -0.5),
        "norm_ffn_g": 1.0 + nrm(ks[20], (L, D_MODEL), 0.02),
        "router_w": nrm(ks[21], (L, D_MODEL, N_EXPERTS), D_MODEL ** -0.5),
        "router_b": nrm(ks[22], (L, N_EXPERTS), 0.01),
        "exp_w_up": nrm(ks[23], (L, N_EXPERTS, D_MODEL, 2 * D_FF_EXPERT), D_MODEL ** -0.5),
        "exp_b_up": nrm(ks[24], (L, N_EXPERTS, 2 * D_FF_EXPERT), 0.02),
        "exp_w_down": nrm(ks[25], (L, N_EXPERTS, D_FF_EXPERT, D_MODEL), D_FF_EXPERT ** -0.5),
        "exp_b_down": nrm(ks[26], (L, N_EXPERTS, D_MODEL), 0.02),
        "final_norm_g": 1.0 + nrm(ks[27], (D_MODEL,), 0.02),
    }


def reference(x, mem, norm_mix_g, w_in, gate_w2_fwd, gate_b_fwd, gate_w2_bwd, gate_b_bwd,
              gla_norm_g, conv_w, conv_b, conv_ln_g, conv_ln_b, w_out, norm_xattn_g,
              norm_mem_g, xattn_wq, xattn_wk, xattn_wv, xattn_wo, norm_ffn_g, router_w,
              router_b, exp_w_up, exp_b_up, exp_w_down, exp_b_down, final_norm_g):
    splits = []
    off = 0
    for size in IN_SIZES[:-1]:
        off += size
        splits.append(off)
    for l in range(DEPTH):
        h = rms_norm(x, norm_mix_g[l])
        q, k, v, r, gf, gb, glu = jnp.split(h @ w_in[l], splits, axis=-1)
        a_out = gla_group(q, k, v, r, gf, gb, gate_w2_fwd[l], gate_b_fwd[l],
                          gate_w2_bwd[l], gate_b_bwd[l], gla_norm_g[l])
        b_out = conv_group(glu, conv_w[l], conv_b[l], conv_ln_g[l], conv_ln_b[l])
        x = x + (jnp.concatenate([a_out, b_out], axis=-1) @ w_out[l]).astype(x.dtype)
        h = rms_norm(x, norm_xattn_g[l])
        m = rms_norm(mem, norm_mem_g[l])
        x = x + memory_cross_attention(h, m, xattn_wq[l], xattn_wk[l], xattn_wv[l],
                                       xattn_wo[l]).astype(x.dtype)
        h = rms_norm(x, norm_ffn_g[l])
        x = x + moe_ffn(h, router_w[l], router_b[l], exp_w_up[l], exp_b_up[l],
                        exp_w_down[l], exp_b_down[l]).astype(x.dtype)
    return rms_norm(x, final_norm_g)
```

```cpp
#include <hip/hip_runtime.h>
#include <cstdio>
#include <cstdint>

#define LAS __attribute__((address_space(3)))
typedef unsigned short bf16_t;
typedef short bf16x8 __attribute__((ext_vector_type(8)));
typedef short bf16x4 __attribute__((ext_vector_type(4)));
typedef float f32x4 __attribute__((ext_vector_type(4)));
typedef float f32x2 __attribute__((ext_vector_type(2)));
typedef float f32x16 __attribute__((ext_vector_type(16)));
typedef unsigned u32x4 __attribute__((ext_vector_type(4)));
typedef unsigned u32x2 __attribute__((ext_vector_type(2)));
#define DI __device__ __forceinline__
#ifndef DBG_GLA
#define DBG_GLA 1
#endif
#ifndef DBG_CONV
#define DBG_CONV 1
#endif
#ifndef DBG_MIX
#define DBG_MIX 1
#endif
#ifndef DBG_ATT
#define DBG_ATT 1
#endif
#ifndef DBG_MOE
#define DBG_MOE 1
#endif
#define ZERO16 ((f32x16){0.f, 0.f, 0.f, 0.f, 0.f, 0.f, 0.f, 0.f, 0.f, 0.f, 0.f, 0.f, 0.f, 0.f, 0.f, 0.f})

constexpr int BATCH = 8, SEQ = 2048, D = 1024, T = BATCH * SEQ;
constexpr int MEMLEN = 256, TM = BATCH * MEMLEN;
constexpr int INW = 2592, NPROJ = 2560;
constexpr int PQ = 0, PK = 256, PV = 512, PR = 1024, PGA = 1536, PGG = 2048;
constexpr int NE = 32, TOPK = 4, FF = 1024;
constexpr int MAXROWS = T * TOPK + NE * 256;
constexpr int NWAVES = 8, NTHREADS = 512;
constexpr float RMS_EPS = 1e-6f, LN_EPS = 1e-5f;

typedef __bf16 bf16v2 __attribute__((ext_vector_type(2)));
DI unsigned pk2(float lo, float hi) { f32x2 v = {lo, hi}; bf16v2 b = __builtin_convertvector(v, bf16v2); return __builtin_bit_cast(unsigned, b); }
DI float bflo(unsigned u) { return __uint_as_float(u << 16); }
DI float bfhi(unsigned u) { return __uint_as_float(u & 0xffff0000u); }
DI float bf1(bf16_t u) { return __uint_as_float(((unsigned)u) << 16); }
DI float wave_sum(float v) {
#pragma unroll
    for (int o = 1; o < 64; o <<= 1) v += __shfl_xor(v, o);
    return v;
}

namespace pg8 {
constexpr int BM = 256, BK = 64, HALF = 128, HTB = HALF * BK * 2, STAGE_BYTES = 8 * HTB;
__host__ __device__ __forceinline__ int lds_byte(int r, int c) { const int st = (r >> 4) * 2 + (c >> 5), rr = r & 15, cc = c & 31, ob = rr * 64 + cc * 2; return st * 1024 + (ob ^ (((ob >> 9) & 1) << 5)); }
__host__ __device__ __forceinline__ void stage_rc(int b, int& R, int& C) { const int st = b / 1024, sb = b % 1024, swz = sb ^ (((sb >> 9) & 1) << 5); R = (st >> 1) * 16 + swz / 64; C = (st & 1) * 32 + (swz % 64) / 2; }
__host__ __device__ __forceinline__ int perm32(int rho) { const int n = rho >> 4, i = rho & 15; return 8 * (i >> 2) + 4 * n + (i & 3); }

struct Unit { int pm, pn, e; };

template <class Epi, class Sched>
DI void gemm_phase(LAS unsigned char* lds, const int K, const Sched& S, const Epi& E) {
    const int tid = threadIdx.x, wid = __builtin_amdgcn_readfirstlane(tid >> 6), lane = tid & 63, wr = wid >> 2, wc = wid & 3, fr = lane & 15, fq = lane >> 4;
    const int nt = K / BK;
    unsigned voffA[2], voffB[2];
#pragma unroll
    for (int i = 0; i < 2; ++i) { int R, C; stage_rc(tid * 16 + i * 8192, R, C); const int Rb = Epi::PERM ? ((R & ~31) + perm32(R & 31)) : R;
        voffA[i] = (unsigned)(R * K + C) * 2u; voffB[i] = (unsigned)(Rb * K + C) * 2u; }
    const size_t kstep = (size_t)(BK * 2);
    const size_t hstep = (size_t)HALF * K * 2;
    const unsigned ldsw = (unsigned)wid * 1024u;
    const int aoff = lds_byte(wr * 64 + fr, fq * 8), boff = lds_byte(wc * 32 + fr, fq * 8);
#define PG8_SA(b, h) (((b) * 2 + (h)) * HTB)
#define PG8_SB(b, h) ((4 + (b) * 2 + (h)) * HTB)
#define PG8_STAGE(bufoff, gbase, voff) do { _Pragma("unroll") for (int _i = 0; _i < 2; ++_i) \
        __builtin_amdgcn_global_load_lds((const unsigned*)((const char*)(gbase) + (voff)[_i]), (LAS unsigned*)(lds + (bufoff) + ldsw + _i * 8192), 16, 0, 0); } while (0)
#define PG8_LDA(dst, b, h) do { _Pragma("unroll") for (int m = 0; m < 4; ++m) _Pragma("unroll") for (int k = 0; k < 2; ++k) dst[m][k] = *(const LAS bf16x8*)(lds + PG8_SA(b, h) + aoff + m * 2048 + k * 1024); } while (0)
#define PG8_LDB(dst, b, h) do { _Pragma("unroll") for (int n = 0; n < 2; ++n) _Pragma("unroll") for (int k = 0; k < 2; ++k) dst[n][k] = *(const LAS bf16x8*)(lds + PG8_SB(b, h) + boff + n * 2048 + k * 1024); } while (0)
#define PG8_MMA(ai, bj, At, Bt) do { __builtin_amdgcn_s_setprio(1); _Pragma("unroll") for (int m = 0; m < 4; ++m) _Pragma("unroll") for (int n = 0; n < 2; ++n) _Pragma("unroll") for (int k = 0; k < 2; ++k) \
        acc[ai][bj][m][n] = __builtin_amdgcn_mfma_f32_16x16x32_bf16(Bt[n][k], At[m][k], acc[ai][bj][m][n], 0, 0, 0); __builtin_amdgcn_s_setprio(0); } while (0)
#define PG8_WAIT_V(n) asm volatile("s_waitcnt vmcnt(" #n ")" ::: "memory")
#define PG8_WAIT_L(n) asm volatile("s_waitcnt lgkmcnt(" #n ")" ::: "memory")
#define PG8_BAR __builtin_amdgcn_s_barrier()
#define PG8_SCHED __builtin_amdgcn_sched_barrier(0)
    Unit cur, nxt; int ui = 0;
    if (!S.next(0, cur)) return;
    f32x4 acc[2][2][4][2];
#pragma unroll
    for (int a = 0; a < 2; ++a)
#pragma unroll
        for (int b = 0; b < 2; ++b)
#pragma unroll
            for (int m = 0; m < 4; ++m)
#pragma unroll
                for (int n = 0; n < 2; ++n) acc[a][b][m][n] = (f32x4){0.f, 0.f, 0.f, 0.f};
    bf16x8 At[4][2], B0[2][2], B1[2][2];
    const char* cA = S.aptr(cur); const char* cB = S.bptr(cur);
    PG8_STAGE(PG8_SB(0, 0), cB, voffB); PG8_STAGE(PG8_SB(0, 1), cB + hstep, voffB); PG8_STAGE(PG8_SA(0, 0), cA, voffA); PG8_STAGE(PG8_SA(0, 1), cA + hstep, voffA);
    if (wr == 1) PG8_BAR;
    PG8_WAIT_V(2); PG8_BAR;
    PG8_STAGE(PG8_SB(1, 0), cB + kstep, voffB); PG8_STAGE(PG8_SA(1, 0), cA + kstep, voffA); PG8_STAGE(PG8_SB(1, 1), cB + hstep + kstep, voffB);
    PG8_WAIT_V(6); PG8_BAR;
    for (;;) {
        const bool has_next = S.next(ui + 1, nxt);
        const char* nA = has_next ? S.aptr(nxt) : cA; const char* nB = has_next ? S.bptr(nxt) : cB;
        for (int t = 0; t < nt; t += 2) {
            const bool last = (t == nt - 2);
            const char* a1 = cA + (size_t)(t + 1) * kstep;
            const char* a2 = last ? nA : cA + (size_t)(t + 2) * kstep; const char* b2 = last ? nB : cB + (size_t)(t + 2) * kstep;
            const char* a3 = a2 + kstep; const char* b3 = b2 + kstep;
            PG8_LDB(B0, 0, 0); PG8_LDB(B1, 0, 1); PG8_SCHED; PG8_LDA(At, 0, 0); PG8_STAGE(PG8_SA(1, 1), a1 + hstep, voffA);
            PG8_WAIT_V(8); PG8_WAIT_L(0); PG8_BAR; PG8_MMA(0, 0, At, B0); PG8_MMA(0, 1, At, B1); PG8_BAR; PG8_SCHED;
            PG8_LDA(At, 0, 1); PG8_STAGE(PG8_SB(0, 0), b2, voffB); PG8_STAGE(PG8_SB(0, 1), b2 + hstep, voffB); PG8_STAGE(PG8_SA(0, 0), a2, voffA);
            PG8_WAIT_V(8); PG8_WAIT_L(0); PG8_BAR; PG8_MMA(1, 0, At, B0); PG8_MMA(1, 1, At, B1); PG8_BAR; PG8_SCHED;
            PG8_LDB(B0, 1, 0); PG8_LDB(B1, 1, 1); PG8_SCHED; PG8_LDA(At, 1, 0); PG8_STAGE(PG8_SA(0, 1), a2 + hstep, voffA);
            PG8_WAIT_V(8); PG8_WAIT_L(0); PG8_BAR; PG8_MMA(0, 0, At, B0); PG8_MMA(0, 1, At, B1); PG8_BAR; PG8_SCHED;
            PG8_LDA(At, 1, 1); PG8_STAGE(PG8_SB(1, 0), b3, voffB); PG8_STAGE(PG8_SB(1, 1), b3 + hstep, voffB); PG8_STAGE(PG8_SA(1, 0), a3, voffA);
            PG8_WAIT_V(8); PG8_WAIT_L(0); PG8_BAR; PG8_MMA(1, 0, At, B0); PG8_MMA(1, 1, At, B1); PG8_BAR; PG8_SCHED;
        }
        if (wr == 0) PG8_BAR;
        E(acc, cur, wr, wc, fr, fq);
        if (!has_next) break;
#pragma unroll
        for (int a = 0; a < 2; ++a)
#pragma unroll
            for (int b = 0; b < 2; ++b)
#pragma unroll
                for (int m = 0; m < 4; ++m)
#pragma unroll
                    for (int n = 0; n < 2; ++n) acc[a][b][m][n] = (f32x4){0.f, 0.f, 0.f, 0.f};
        cur = nxt; cA = nA; cB = nB; ++ui;
        if (wr == 1) PG8_BAR;
    }
    PG8_WAIT_V(0);
    PG8_BAR;
#undef PG8_SA
#undef PG8_SB
#undef PG8_STAGE
#undef PG8_LDA
#undef PG8_LDB
#undef PG8_MMA
#undef PG8_WAIT_V
#undef PG8_WAIT_L
#undef PG8_BAR
#undef PG8_SCHED
}
}

#define XB_TMO      128
#define XB_XCNT(j)  (256  + 64 * (j))
#define XB_XSUB(j)  (1280 + 64 * (j))
#define XB_XGEN(j)  (2304 + 64 * (j))
#define XB_TOP      3328
#define XB_TOPGEN   3392
#define XCD_BAR_WORDS 3456
#define XB_SPIN_CAP (1u << 18)

__device__ __forceinline__ unsigned xb_ld(unsigned* p)              { return __hip_atomic_load(p, __ATOMIC_RELAXED, __HIP_MEMORY_SCOPE_AGENT); }
__device__ __forceinline__ unsigned xb_add(unsigned* p, unsigned v) { return __hip_atomic_fetch_add(p, v, __ATOMIC_RELAXED, __HIP_MEMORY_SCOPE_AGENT); }
__device__ __forceinline__ unsigned xb_xcc_id() { return (unsigned)__builtin_amdgcn_s_getreg((3 << 11) | 20) & 0xFu; }
#define XB_SPIN(cond, bar) do { unsigned _sp = 0; while (cond) { __builtin_amdgcn_s_sleep(1); \
    if ((++_sp & 255u) == 0u) { if (xb_ld(&(bar)[XB_TMO])) break; if (_sp > XB_SPIN_CAP) { atomicAdd(&(bar)[XB_TMO], 1u); break; } } } } while (0)

struct XcdBarrier { unsigned* bar; unsigned x; volatile LAS unsigned* st; };

__device__ __forceinline__ XcdBarrier xcd_barrier_post(unsigned* bar, volatile LAS unsigned* st) {
    XcdBarrier b; b.bar = bar; b.x = xb_xcc_id(); b.st = st;
    if (threadIdx.x == 0) (void)xb_add(&bar[XB_XCNT(b.x)], 1u);
    return b;
}
__device__ __forceinline__ void xcd_barrier_complete(unsigned* bar, unsigned x, unsigned& nloc, unsigned& nx) {
    const unsigned G = gridDim.x * gridDim.y * gridDim.z;
    unsigned sum, cnt, mine, sp = 0u;
    for (;;) {
        sum = 0u; cnt = 0u; mine = 0u;
#pragma unroll
        for (unsigned j = 0; j < 16; ++j) { const unsigned c = xb_ld(&bar[XB_XCNT(j)]); sum += c; cnt += (c > 0u) ? 1u : 0u; mine = (j == x) ? c : mine; }
        if (sum == G) break;
        __builtin_amdgcn_s_sleep(1);
        if ((++sp & 255u) == 0u) { if (xb_ld(&bar[XB_TMO])) break; if (sp > XB_SPIN_CAP) { atomicAdd(&bar[XB_TMO], 1u); break; } }
    }
    nloc = mine > 0u ? mine : 1u; nx = cnt > 0u ? cnt : 1u;
}
__device__ __forceinline__ void xcd_barrier(const XcdBarrier& b) {
    asm volatile("s_waitcnt vmcnt(0)" ::: "memory");
    __syncthreads();
    if (threadIdx.x == 0) {
        unsigned* bar = b.bar;
        __builtin_amdgcn_s_waitcnt(0);
        unsigned nloc = b.st[0], nx = b.st[1];
        if (nloc == 0u) { xcd_barrier_complete(bar, b.x, nloc, nx); b.st[0] = nloc; b.st[1] = nx; }
        const unsigned old = xb_add(&bar[XB_XSUB(b.x)], 1u);
        const unsigned gen = old / nloc;
        if (old + 1u == (gen + 1u) * nloc) {
            __builtin_amdgcn_fence(__ATOMIC_RELEASE, "agent");
            asm volatile("s_waitcnt vmcnt(0)" ::: "memory");
            const unsigned og = xb_add(&bar[XB_TOP], 1u);
            const unsigned tg = og / nx;
            if (og + 1u == (tg + 1u) * nx) xb_add(&bar[XB_TOPGEN], 1u);
            else XB_SPIN(xb_ld(&bar[XB_TOPGEN]) == tg, bar);
            __builtin_amdgcn_fence(__ATOMIC_ACQUIRE, "agent");
            xb_add(&bar[XB_XGEN(b.x)], 1u);
            asm volatile("s_waitcnt vmcnt(0)" ::: "memory");
        } else {
            XB_SPIN(xb_ld(&bar[XB_XGEN(b.x)]) == gen, bar);
            __builtin_amdgcn_fence(__ATOMIC_ACQUIRE, "agent");
            asm volatile("s_waitcnt vmcnt(0)" ::: "memory");
        }
    }
    __syncthreads();
}

constexpr size_t MiB = 1u << 20;
constexpr size_t WS_CTL = 0, CTL_ZERO_BYTES = 1 * MiB;
constexpr size_t CTL_BAR = 0, CTL_CNT = 16384, CTL_SSQ2 = 65536;
constexpr size_t WS_RSTD1 = 1 * MiB, WS_RSTDM = WS_RSTD1 + 65536, WS_RSTD3 = WS_RSTDM + 65536;
constexpr size_t WS_GRAW = 2 * MiB;
constexpr size_t WS_EIDX = 4 * MiB, WS_SLOT = 5 * MiB, WS_GATE = 6 * MiB, WS_DPOS = 7 * MiB;
constexpr size_t WS_RSP = 8 * MiB;
constexpr size_t WS_WIN = 16 * MiB, WS_WOUT = 22 * MiB, WS_WQ = 24 * MiB, WS_WKV = 26 * MiB, WS_WO = 30 * MiB;
constexpr size_t WS_WUP = 32 * MiB, WS_WDN = 160 * MiB;
constexpr size_t WS_MEMB = 224 * MiB, WS_KX = 228 * MiB, WS_VT = 232 * MiB;
constexpr size_t WS_AB = 236 * MiB;
constexpr size_t WS_PROJ = 268 * MiB;
constexpr size_t WS_OFB = 348 * MiB;
constexpr size_t WS_CAT = 380 * MiB;
constexpr size_t WS_Q = 412 * MiB, WS_AO = 444 * MiB;
constexpr size_t WS_XS = 268 * MiB;
constexpr size_t WS_HID = 476 * MiB;
constexpr size_t WS_YS = 268 * MiB;
constexpr size_t WS_END = 620 * MiB;
static_assert((size_t)MAXROWS * D * 2 == 144 * MiB, "packed buffers are 144 MiB");

constexpr int LDS_BYTES = 147456, MISC_OFF = LDS_BYTES - 2048;

struct Params {
    const float* in[28]; float* out; unsigned char* ws; int ph_lo, ph_hi;
};

struct Ctx {
    LAS unsigned char* lds; int tid, lane, wave, G, vcu;
};

DI void transpose_item(const float* W, int ldw, int k0, int n0, const float* scale, bf16_t* WT, int drow0, int K, LAS float* scr, int lane) {
#pragma unroll 8
    for (int i = 0; i < 32; ++i) { const int kk = 2 * i + (lane >> 5); float v = W[(size_t)(k0 + kk) * ldw + n0 + (lane & 31)]; if (scale) v *= scale[k0 + kk]; scr[kk * 33 + (lane & 31)] = v; }
    asm volatile("s_waitcnt lgkmcnt(0)" ::: "memory");
    const int c = lane & 7;
#pragma unroll
    for (int j = 0; j < 4; ++j) { const int n = (lane >> 3) + 8 * j; const LAS float* s = scr + (8 * c) * 33 + n;
        u32x4 o; o.x = pk2(s[0 * 33], s[1 * 33]); o.y = pk2(s[2 * 33], s[3 * 33]); o.z = pk2(s[4 * 33], s[5 * 33]); o.w = pk2(s[6 * 33], s[7 * 33]);
        *(u32x4*)(WT + (size_t)(drow0 + n) * K + k0 + 8 * c) = o; }
    asm volatile("s_waitcnt lgkmcnt(0)" ::: "memory");
}

DI void p0_weights(const Params& p, const Ctx& F) {
    LAS float* scr = (LAS float*)(F.lds + F.wave * 16384);
    const int gw = F.vcu * NWAVES + F.wave, NGW = F.G * NWAVES;
    unsigned char* ws = p.ws;
    constexpr int I_IN = 16 * 81, I_SQ = 16 * 32, I_UP = 16 * 64 * NE, I_DN = 16 * 32 * NE;
    constexpr int NITEMS = I_IN + 5 * I_SQ + I_UP + I_DN;
    for (int it = gw; it < NITEMS; it += NGW) {
        int r = it;
        if (r < I_IN) { const int kb = r / 81, nb = r % 81; if (nb == 48) continue;
            transpose_item(p.in[3], INW, 64 * kb, 32 * nb, p.in[2], (bf16_t*)(ws + WS_WIN), nb < 48 ? 32 * nb : 32 * nb - 32, D, scr, F.lane); continue; }
        r -= I_IN;
        if (r < 5 * I_SQ) { const int m = r / I_SQ, q = r % I_SQ, kb = q / 32, nb = q % 32;
            const float* W = m == 0 ? p.in[13] : m == 1 ? p.in[16] : m == 2 ? p.in[17] : m == 3 ? p.in[18] : p.in[19];
            const float* sc = m == 1 ? p.in[14] : (m == 2 || m == 3) ? p.in[15] : nullptr;
            bf16_t* dst = (bf16_t*)(ws + (m == 0 ? WS_WOUT : m == 1 ? WS_WQ : m == 2 ? WS_WKV : m == 3 ? WS_WKV : WS_WO));
            transpose_item(W, D, 64 * kb, 32 * nb, sc, dst, (m == 3 ? D : 0) + 32 * nb, D, scr, F.lane); continue; }
        r -= 5 * I_SQ;
        if (r < I_UP) { const int e = r / (16 * 64), q = r % (16 * 64), kb = q / 64, nb = q % 64; const int n0 = 32 * nb;
            const int drow = n0 < FF ? (n0 / 128) * 256 + (n0 % 128) : ((n0 - FF) / 128) * 256 + 128 + ((n0 - FF) % 128);
            transpose_item(p.in[23] + (size_t)e * D * 2 * FF, 2 * FF, 64 * kb, n0, p.in[20], (bf16_t*)(ws + WS_WUP) + (size_t)e * 2 * FF * D, drow, D, scr, F.lane); continue; }
        r -= I_UP;
        { const int e = r / (16 * 32), q = r % (16 * 32), kb = q / 32, nb = q % 32;
            transpose_item(p.in[25] + (size_t)e * FF * D, D, 64 * kb, 32 * nb, nullptr, (bf16_t*)(ws + WS_WDN) + (size_t)e * D * FF, 32 * nb, FF, scr, F.lane); }
    }
}

DI void p0_mem(const Params& p, const Ctx& F) {
    const int gw = F.vcu * NWAVES + F.wave, NGW = F.G * NWAVES;
    const float* mem = p.in[1]; bf16_t* memb = (bf16_t*)(p.ws + WS_MEMB); float* rstdm = (float*)(p.ws + WS_RSTDM);
    for (int m = gw; m < TM; m += NGW) {
        const f32x4* xr = (const f32x4*)(mem + (size_t)m * D) + F.lane;
        f32x4 v[4]; float s = 0.f;
#pragma unroll
        for (int j = 0; j < 4; ++j) { v[j] = xr[64 * j]; s += (v[j].x * v[j].x + v[j].y * v[j].y) + (v[j].z * v[j].z + v[j].w * v[j].w); }
        s = wave_sum(s);
        u32x2* o8 = (u32x2*)(memb + (size_t)m * D) + F.lane;
#pragma unroll
        for (int j = 0; j < 4; ++j) { u32x2 w; w.x = pk2(v[j].x, v[j].y); w.y = pk2(v[j].z, v[j].w); o8[64 * j] = w; }
        if (F.lane == 0) rstdm[m] = rsqrtf(s * (1.f / D) + RMS_EPS);
    }
}

constexpr int WF_PITCH = 1028;
template <int MODE>
DI void skinny_phase(const Params& p, const Ctx& F, const float* X, const float* W, int ldw, const float* gain, bf16_t* XB, float* RSTD) {
    LAS float* Wf = (LAS float*)F.lds;
    const int rg = F.wave & 1, kq = F.wave >> 1, l31 = F.lane & 31, h = F.lane >> 5;
    for (int tile = F.vcu; tile < T / 64; tile += F.G) {
        __syncthreads();
        for (int it = 0; it < 16; ++it) { const int k = (F.tid >> 3) + 64 * it, n4 = (F.tid & 7) * 4;
            const f32x4 w = *(const f32x4*)(W + (size_t)k * ldw + n4); const float g = gain[k];
            Wf[(n4 + 0) * WF_PITCH + k] = w.x * g; Wf[(n4 + 1) * WF_PITCH + k] = w.y * g; Wf[(n4 + 2) * WF_PITCH + k] = w.z * g; Wf[(n4 + 3) * WF_PITCH + k] = w.w * g; }
        __syncthreads();
        const int row = tile * 64 + rg * 32 + l31;
        const float* xr = X + (size_t)row * D + kq * 256 + 4 * h;
        bf16_t* xbr = XB + (size_t)row * D + kq * 256 + 4 * h;
        const LAS float* wr_ = Wf + l31 * WF_PITCH + kq * 256 + 4 * h;
        f32x16 acc = ZERO16;
        float ss = 0.f;
#pragma unroll 8
        for (int kb = 0; kb < 256; kb += 8) {
            const f32x4 xv = *(const f32x4*)(xr + kb); const f32x4 wv = *(const LAS f32x4*)(wr_ + kb);
            ss += (xv.x * xv.x + xv.y * xv.y) + (xv.z * xv.z + xv.w * xv.w);
            acc = __builtin_amdgcn_mfma_f32_32x32x2f32(xv.x, wv.x, acc, 0, 0, 0);
            acc = __builtin_amdgcn_mfma_f32_32x32x2f32(xv.y, wv.y, acc, 0, 0, 0);
            acc = __builtin_amdgcn_mfma_f32_32x32x2f32(xv.z, wv.z, acc, 0, 0, 0);
            acc = __builtin_amdgcn_mfma_f32_32x32x2f32(xv.w, wv.w, acc, 0, 0, 0);
            u32x2 o; o.x = pk2(xv.x, xv.y); o.y = pk2(xv.z, xv.w); *(u32x2*)(xbr + kb) = o;
        }
        ss += __shfl_xor(ss, 32);
        __syncthreads();
        LAS float* red = (LAS float*)F.lds;
        LAS float* ssq = red + 4 * 64 * 33;
        LAS float* LG = ssq + 4 * 64;
        LAS int* lcnt = (LAS int*)(LG + 64 * 33);
#pragma unroll
        for (int i = 0; i < 16; ++i) { const int rr = rg * 32 + (i & 3) + 8 * (i >> 2) + 4 * h; red[(kq * 64 + rr) * 33 + l31] = acc[i]; }
        if (h == 0) ssq[kq * 64 + rg * 32 + l31] = ss;
        if (MODE == 1 && F.tid < 64) lcnt[F.tid] = 0;
        __syncthreads();
        {
            const int r = F.tid >> 3, n0 = (F.tid & 7) * 4;
            const float s2 = (ssq[r] + ssq[64 + r]) + (ssq[128 + r] + ssq[192 + r]);
            const float rstd = rsqrtf(s2 * (1.f / D) + RMS_EPS);
            float v[4];
#pragma unroll
            for (int i = 0; i < 4; ++i) v[i] = ((red[(0 * 64 + r) * 33 + n0 + i] + red[(1 * 64 + r) * 33 + n0 + i]) + (red[(2 * 64 + r) * 33 + n0 + i] + red[(3 * 64 + r) * 33 + n0 + i])) * rstd;
            const int grow = tile * 64 + r;
            if ((F.tid & 7) == 0) RSTD[grow] = rstd;
            if (MODE == 0) { *(f32x4*)((float*)(p.ws + WS_GRAW) + (size_t)grow * 32 + n0) = (f32x4){v[0], v[1], v[2], v[3]}; }
            else {
#pragma unroll
                for (int i = 0; i < 4; ++i) LG[r * 33 + n0 + i] = v[i] + p.in[22][n0 + i];
            }
        }
        if (MODE == 1) {
            __syncthreads();
            int e4[4]; float g4[4]; int rk[4];
            if (F.tid < 64) {
                float v[32];
#pragma unroll
                for (int n = 0; n < 32; ++n) v[n] = LG[F.tid * 33 + n];
                float tv[4];
#pragma unroll
                for (int k = 0; k < 4; ++k) { float best = -INFINITY; int bi = 0;
#pragma unroll
                    for (int n = 0; n < 32; ++n) { const bool tk = v[n] > best; best = tk ? v[n] : best; bi = tk ? n : bi; }
                    tv[k] = best; e4[k] = bi;
#pragma unroll
                    for (int n = 0; n < 32; ++n) v[n] = (n == bi) ? -INFINITY : v[n]; }
                float den = 0.f;
#pragma unroll
                for (int k = 0; k < 4; ++k) { g4[k] = __expf(tv[k] - tv[0]); den += g4[k]; }
                const float inv = 1.f / den;
#pragma unroll
                for (int k = 0; k < 4; ++k) { g4[k] *= inv; rk[k] = atomicAdd((int*)&lcnt[e4[k]], 1); }
            }
            __syncthreads();
            if (F.tid < 32) { const int c = lcnt[F.tid]; lcnt[32 + F.tid] = c > 0 ? (int)atomicAdd((unsigned*)(p.ws + WS_CTL + CTL_CNT) + F.tid, (unsigned)c) : 0; }
            __syncthreads();
            if (F.tid < 64) { const int grow = tile * 64 + F.tid;
                int* eidx = (int*)(p.ws + WS_EIDX) + grow * 4; int* slot = (int*)(p.ws + WS_SLOT) + grow * 4; float* gate = (float*)(p.ws + WS_GATE) + grow * 4;
#pragma unroll
                for (int k = 0; k < 4; ++k) { eidx[k] = e4[k]; slot[k] = lcnt[32 + e4[k]] + rk[k]; gate[k] = g4[k]; } }
        }
    }
}

using pg8::Unit;
constexpr size_t PANEL = (size_t)256 * D * 2;
struct SchedInKV {
    const char *A0, *B0, *A1, *B1; int G, c;
    DI bool next(int i, Unit& u) const {
        const int L = i * G + c; if (L >= 704) return false;
        if (L < 640) { const int x = L & 7, o = L >> 3; u.pm = x * 8 + (o & 7); u.pn = o >> 3; u.e = 0; }
        else { const int j = L - 640; u.pm = j & 7; u.pn = j >> 3; u.e = 1; }
        return true; }
    DI const char* aptr(const Unit& u) const { return (u.e ? A1 : A0) + (size_t)u.pm * PANEL; }
    DI const char* bptr(const Unit& u) const { return (u.e ? B1 : B0) + (size_t)u.pn * PANEL; }
};
struct SchedPlain {
    const char *A, *B; int G, c, nN;
    DI bool next(int i, Unit& u) const {
        const int L = i * G + c; if (L >= 64 * nN) return false;
        const int x = L & 7, o = L >> 3; u.pm = x * 8 + (o & 7); u.pn = o >> 3; u.e = 0; return true; }
    DI const char* aptr(const Unit& u) const { return A + (size_t)u.pm * PANEL; }
    DI const char* bptr(const Unit& u) const { return B + (size_t)u.pn * PANEL; }
};
struct SchedMoE {
    const char *A, *B; size_t bstride; const LAS int* tile_e; int MT, G, vcu, nN;
    DI bool next(int i, Unit& u) const {
        const int L = i * G + vcu, chunk = L >> 5, j = L & 31;
        int mt, pn; if (nN == 8) { mt = chunk * 4 + (j & 3); pn = j >> 2; } else { mt = chunk * 8 + (j & 7); pn = j >> 3; }
        if (mt >= MT) return false;
        u.pm = mt; u.pn = pn; u.e = tile_e[mt]; return true; }
    DI const char* aptr(const Unit& u) const { return A + (size_t)u.pm * PANEL; }
    DI const char* bptr(const Unit& u) const { return B + (size_t)u.e * bstride + (size_t)u.pn * PANEL; }
};

typedef f32x4 AccT[2][2][4][2];
struct EpiInKV {
    static constexpr bool PERM = true;
    bf16_t* proj; const float* rstd1; bf16_t* kx; bf16_t* vT; const float* rstdm;
    DI void operator()(const AccT& acc, const Unit& u, int wr, int wc, int fr, int fq) const {
        const int row0 = u.pm * 256 + wr * 64 + fr;
        if (u.e == 0 || u.pn < 4) {
            bf16_t* base = u.e == 0 ? proj : kx; const int ldc = u.e == 0 ? NPROJ : D; const float* rs_ = u.e == 0 ? rstd1 : rstdm;
            const int col0 = u.pn * 256 + wc * 32 + 8 * fq;
#pragma unroll
            for (int ai = 0; ai < 2; ++ai)
#pragma unroll
                for (int m = 0; m < 4; ++m) { const int row = row0 + ai * 128 + m * 16; const float rs = rs_[row]; bf16_t* rowp = base + (size_t)row * ldc + col0;
#pragma unroll
                    for (int bj = 0; bj < 2; ++bj) { const f32x4 v0 = acc[ai][bj][m][0] * rs, v1 = acc[ai][bj][m][1] * rs;
                        u32x4 w; w.x = pk2(v0[0], v0[1]); w.y = pk2(v0[2], v0[3]); w.z = pk2(v1[0], v1[1]); w.w = pk2(v1[2], v1[3]);
                        *(u32x4*)(rowp + bj * 128) = w; } }
        } else {
            const int d0 = (u.pn - 4) * 256 + wc * 32 + 8 * fq;
#pragma unroll
            for (int ai = 0; ai < 2; ++ai)
#pragma unroll
                for (int m = 0; m < 4; ++m) { const int row = row0 + ai * 128 + m * 16; const float rs = rstdm[row]; const int b = row >> 8, key = row & 255;
#pragma unroll
                    for (int bj = 0; bj < 2; ++bj)
#pragma unroll
                        for (int n = 0; n < 2; ++n)
#pragma unroll
                            for (int i = 0; i < 4; ++i) { const int dc = d0 + bj * 128 + 4 * n + i;
                                vT[((size_t)(b * D + dc)) * 256 + key] = (bf16_t)(pk2(acc[ai][bj][m][n][i] * rs, 0.f) & 0xffffu); } }
        }
    }
};
struct EpiOut {
    static constexpr bool PERM = true;
    const float* x; float* xr; bf16_t* xb; float* ssq;
    DI void operator()(const AccT& acc, const Unit& u, int wr, int wc, int fr, int fq) const {
        const int row0 = u.pm * 256 + wr * 64 + fr, col0 = u.pn * 256 + wc * 32 + 8 * fq;
#pragma unroll
        for (int ai = 0; ai < 2; ++ai)
#pragma unroll
            for (int m = 0; m < 4; ++m) { const int row = row0 + ai * 128 + m * 16; const size_t off = (size_t)row * D + col0; float s = 0.f;
#pragma unroll
                for (int bj = 0; bj < 2; ++bj) {
                    const f32x4 zz = (f32x4){0.f, 0.f, 0.f, 0.f}; const f32x4 v0 = (DBG_MIX ? acc[ai][bj][m][0] : zz) + *(const f32x4*)(x + off + bj * 128), v1 = (DBG_MIX ? acc[ai][bj][m][1] : zz) + *(const f32x4*)(x + off + bj * 128 + 4);
                    *(f32x4*)(xr + off + bj * 128) = v0; *(f32x4*)(xr + off + bj * 128 + 4) = v1;
                    u32x4 w; w.x = pk2(v0[0], v0[1]); w.y = pk2(v0[2], v0[3]); w.z = pk2(v1[0], v1[1]); w.w = pk2(v1[2], v1[3]);
                    *(u32x4*)(xb + off + bj * 128) = w;
                    s += (v0[0] * v0[0] + v0[1] * v0[1]) + (v0[2] * v0[2] + v0[3] * v0[3]) + (v1[0] * v1[0] + v1[1] * v1[1]) + (v1[2] * v1[2] + v1[3] * v1[3]); }
                s += __shfl_xor(s, 16); s += __shfl_xor(s, 32);
                if (fq == 0) atomicAdd(ssq + row, s); }
    }
};
struct EpiQ {
    static constexpr bool PERM = true;
    bf16_t* q; const float* ssq;
    DI void operator()(const AccT& acc, const Unit& u, int wr, int wc, int fr, int fq) const {
        const int row0 = u.pm * 256 + wr * 64 + fr, col0 = u.pn * 256 + wc * 32 + 8 * fq;
#pragma unroll
        for (int ai = 0; ai < 2; ++ai)
#pragma unroll
            for (int m = 0; m < 4; ++m) { const int row = row0 + ai * 128 + m * 16; const float rs = rsqrtf(ssq[row] * (1.f / D) + RMS_EPS); bf16_t* rowp = q + (size_t)row * D + col0;
#pragma unroll
                for (int bj = 0; bj < 2; ++bj) { const f32x4 v0 = acc[ai][bj][m][0] * rs, v1 = acc[ai][bj][m][1] * rs;
                    u32x4 w; w.x = pk2(v0[0], v0[1]); w.y = pk2(v0[2], v0[3]); w.z = pk2(v1[0], v1[1]); w.w = pk2(v1[2], v1[3]);
                    *(u32x4*)(rowp + bj * 128) = w; } }
    }
};
struct EpiWo {
    static constexpr bool PERM = false;
    float* xr;
    DI void operator()(const AccT& acc, const Unit& u, int wr, int wc, int fr, int fq) const {
        const int row0 = u.pm * 256 + wr * 64 + fr, col0 = u.pn * 256 + wc * 32 + 4 * fq;
#pragma unroll
        for (int ai = 0; ai < 2; ++ai)
#pragma unroll
            for (int m = 0; m < 4; ++m) { float* rowp = xr + (size_t)(row0 + ai * 128 + m * 16) * D + col0;
#pragma unroll
                for (int bj = 0; bj < 2; ++bj)
#pragma unroll
                    for (int n = 0; n < 2; ++n) { f32x4* pp = (f32x4*)(rowp + bj * 128 + n * 16); if (DBG_ATT) *pp = *pp + acc[ai][bj][m][n]; } }
    }
};
struct EpiUp {
    static constexpr bool PERM = true;
    bf16_t* hid; const float* rsp; const float* b_up;
    DI void operator()(const AccT& acc, const Unit& u, int wr, int wc, int fr, int fq) const {
        const int row0 = u.pm * 256 + wr * 64 + fr, c0 = u.pn * 128 + wc * 32 + 8 * fq;
        const float* bg = b_up + (size_t)u.e * 2 * FF + c0; const float* bl = bg + FF;
        const f32x4 bg0 = *(const f32x4*)bg, bg1 = *(const f32x4*)(bg + 4), bl0 = *(const f32x4*)bl, bl1 = *(const f32x4*)(bl + 4);
#pragma unroll
        for (int ai = 0; ai < 2; ++ai)
#pragma unroll
            for (int m = 0; m < 4; ++m) { const int row = row0 + ai * 128 + m * 16; const float rs = rsp[row];
                float hv[8];
#pragma unroll
                for (int n = 0; n < 2; ++n)
#pragma unroll
                    for (int i = 0; i < 4; ++i) {
                        const float g = fminf(acc[ai][0][m][n][i] * rs + (n ? bg1[i] : bg0[i]), 7.0f);
                        const float l = fminf(fmaxf(acc[ai][1][m][n][i] * rs + (n ? bl1[i] : bl0[i]), -7.0f), 7.0f);
                        hv[4 * n + i] = g * __builtin_amdgcn_rcpf(1.0f + __expf(-1.702f * g)) * (l + 1.0f); }
                u32x4 w; w.x = pk2(hv[0], hv[1]); w.y = pk2(hv[2], hv[3]); w.z = pk2(hv[4], hv[5]); w.w = pk2(hv[6], hv[7]);
                *(u32x4*)(hid + (size_t)row * FF + c0) = w; }
    }
};
struct EpiDn {
    static constexpr bool PERM = true;
    bf16_t* ys; const float* b_dn;
    DI void operator()(const AccT& acc, const Unit& u, int wr, int wc, int fr, int fq) const {
        const int row0 = u.pm * 256 + wr * 64 + fr, col0 = u.pn * 256 + wc * 32 + 8 * fq;
        const float* bb = b_dn + (size_t)u.e * D + col0;
        f32x4 bv[2][2];
#pragma unroll
        for (int bj = 0; bj < 2; ++bj) { bv[bj][0] = *(const f32x4*)(bb + bj * 128); bv[bj][1] = *(const f32x4*)(bb + bj * 128 + 4); }
#pragma unroll
        for (int ai = 0; ai < 2; ++ai)
#pragma unroll
            for (int m = 0; m < 4; ++m) { bf16_t* rowp = ys + (size_t)(row0 + ai * 128 + m * 16) * D + col0;
#pragma unroll
                for (int bj = 0; bj < 2; ++bj) { const f32x4 v0 = acc[ai][bj][m][0] + bv[bj][0], v1 = acc[ai][bj][m][1] + bv[bj][1];
                    u32x4 w; w.x = pk2(v0[0], v0[1]); w.y = pk2(v0[2], v0[3]); w.z = pk2(v1[0], v1[1]); w.w = pk2(v1[2], v1[3]);
                    *(u32x4*)(rowp + bj * 128) = w; } }
    }
};

DI void conv_tile(const Params& p, const Ctx& F, int tile) {
    const bf16_t* proj = (const bf16_t*)(p.ws + WS_PROJ); bf16_t* cat = (bf16_t*)(p.ws + WS_CAT);
    LAS bf16_t* U = (LAS bf16_t*)F.lds;
    const int b = tile >> 5, t0 = (tile & 31) * 64;
    __syncthreads();
    for (int it = F.tid; it < 94 * 64; it += NTHREADS) { const int r = it >> 6, c8 = (it & 63) * 8, t = t0 - 15 + r;
        u32x4 o = (u32x4){0u, 0u, 0u, 0u};
        if (t >= 0 && t < SEQ) { const bf16_t* rowp = proj + (size_t)(b * SEQ + t) * NPROJ;
            const u32x4 a = *(const u32x4*)(rowp + PGA + c8), g = *(const u32x4*)(rowp + PGG + c8);
#pragma unroll
            for (int j = 0; j < 4; ++j) { const float a0 = bflo(a[j]), a1 = bfhi(a[j]), g0 = bflo(g[j]), g1 = bfhi(g[j]);
                o[j] = pk2(a0 * __builtin_amdgcn_rcpf(1.f + __expf(-g0)), a1 * __builtin_amdgcn_rcpf(1.f + __expf(-g1))); } }
        *(LAS u32x4*)(U + r * 512 + c8) = o; }
    __syncthreads();
    {
        const int c = F.tid; const float* cw = p.in[9];
        float w[31];
#pragma unroll
        for (int j = 0; j < 31; ++j) w[j] = cw[j * 512 + c];
        const float bias = p.in[10][c];
        float win[31];
#pragma unroll
        for (int r = 0; r < 30; ++r) win[r] = bf1(U[r * 512 + c]);
#pragma unroll
        for (int t = 0; t < 64; ++t) {
            win[(t + 30) % 31] = bf1(U[(t + 30) * 512 + c]);
            float y = bias;
#pragma unroll
            for (int j = 0; j < 31; ++j) y += w[j] * win[(t + j) % 31];
            U[t * 512 + c] = (bf16_t)(pk2(y, 0.f) & 0xffffu);
        }
    }
    __syncthreads();
    {
        const float* lg = p.in[11]; const float* lb = p.in[12];
        const f32x4 g0 = *(const f32x4*)(lg + 8 * F.lane), g1 = *(const f32x4*)(lg + 8 * F.lane + 4), b0 = *(const f32x4*)(lb + 8 * F.lane), b1 = *(const f32x4*)(lb + 8 * F.lane + 4);
        for (int t = F.wave; t < 64; t += NWAVES) {
            const u32x4 raw = *(const LAS u32x4*)(U + t * 512 + 8 * F.lane);
            float v[8];
#pragma unroll
            for (int j = 0; j < 4; ++j) { v[2 * j] = bflo(raw[j]); v[2 * j + 1] = bfhi(raw[j]); }
            float s = 0.f;
#pragma unroll
            for (int j = 0; j < 8; ++j) s += v[j];
            const float mu = wave_sum(s) * (1.f / 512.f); float q = 0.f;
#pragma unroll
            for (int j = 0; j < 8; ++j) { v[j] -= mu; q += v[j] * v[j]; }
            const float rstd = rsqrtf(wave_sum(q) * (1.f / 512.f) + LN_EPS);
            float o[8];
#pragma unroll
            for (int j = 0; j < 8; ++j) { const float y = v[j] * rstd * (j < 4 ? g0[j & 3] : g1[j & 3]) + (j < 4 ? b0[j & 3] : b1[j & 3]); o[j] = y * __builtin_amdgcn_rcpf(1.f + __expf(-y)); }
            u32x4 w4; w4.x = pk2(o[0], o[1]); w4.y = pk2(o[2], o[3]); w4.z = pk2(o[4], o[5]); w4.w = pk2(o[6], o[7]);
            if (!DBG_CONV) w4 = (u32x4){0u, 0u, 0u, 0u};
            *(u32x4*)(cat + (size_t)(b * SEQ + t0 + t) * D + 512 + 8 * F.lane) = w4;
        }
    }
}

DI bf16x8 lds_frag(const LAS bf16_t* base, int row, int k) { return *(const LAS bf16x8*)(base + row * 72 + k); }
DI void gla_unit(const Params& p, const Ctx& F, int unit) {
    const int b = unit >> 5, hh = (unit >> 3) & 3, dir = (unit >> 2) & 1, dvs = unit & 3;
    const bf16_t* proj = (const bf16_t*)(p.ws + WS_PROJ); const float* graw = (const float*)(p.ws + WS_GRAW);
    bf16_t* obuf = (bf16_t*)(p.ws + WS_OFB) + (size_t)dir * T * 512;
    LAS float* gfs = (LAS float*)(F.lds);
    LAS float* segtot = (LAS float*)(F.lds + 4096);
    LAS float* a_s = (LAS float*)(F.lds + 6144);
    LAS bf16_t* Qt = (LAS bf16_t*)(F.lds + 8192);
    LAS bf16_t* Kt = (LAS bf16_t*)(F.lds + 17408);
    LAS bf16_t* KhT = (LAS bf16_t*)(F.lds + 26624);
    LAS bf16_t* P = (LAS bf16_t*)(F.lds + 35840);
    LAS bf16_t* vT = (LAS bf16_t*)(F.lds + 45056);
    LAS bf16_t* ST = (LAS bf16_t*)(F.lds + 49664);
    const int d = F.tid & 63, w = F.wave, lane = F.lane;
    const float* w2 = p.in[dir ? 6 : 4]; const float* gb = p.in[dir ? 7 : 5];
    float w2r[16];
#pragma unroll
    for (int r = 0; r < 16; ++r) w2r[r] = w2[r * 256 + hh * 64 + d];
    const float gbias = gb[hh * 64 + d];
    __syncthreads();
    for (int i = F.tid; i < 32 * 72 / 2; i += NTHREADS) ((LAS unsigned*)ST)[i] = 0u;
    f32x4 Sacc = (f32x4){0.f, 0.f, 0.f, 0.f};
    bf16_t qr[8], kr[8]; u32x2 vr; f32x4 gr;
    const int vj = F.tid >> 3, vc4 = (F.tid & 7) * 4, gj = F.tid >> 2, gr4 = (F.tid & 3) * 4;
#define GLA_TOK(n, j) (b * SEQ + (dir ? (SEQ - 1 - ((n) * 64 + (j))) : ((n) * 64 + (j))))
#define GLA_PREFETCH(n) do { \
        _Pragma("unroll") for (int r = 0; r < 8; ++r) { const bf16_t* rp = proj + (size_t)GLA_TOK(n, 8 * w + r) * NPROJ + hh * 64 + d; qr[r] = rp[PQ]; kr[r] = rp[PK]; } \
        vr = *(const u32x2*)(proj + (size_t)GLA_TOK(n, vj) * NPROJ + PV + hh * 128 + dvs * 32 + vc4); \
        if (F.tid < 256) gr = *(const f32x4*)(graw + (size_t)GLA_TOK(n, gj) * 32 + dir * 16 + gr4); } while (0)
    GLA_PREFETCH(0);
    for (int n = 0; n < 32; ++n) {
        { const bf16_t v0 = (bf16_t)(vr.x & 0xffffu), v1 = (bf16_t)(vr.x >> 16), v2 = (bf16_t)(vr.y & 0xffffu), v3 = (bf16_t)(vr.y >> 16);
          vT[(vc4 + 0) * 72 + vj] = v0; vT[(vc4 + 1) * 72 + vj] = v1; vT[(vc4 + 2) * 72 + vj] = v2; vT[(vc4 + 3) * 72 + vj] = v3;
          if (F.tid < 256) *(LAS f32x4*)(gfs + gj * 16 + gr4) = gr; }
        float qv[8], kv[8];
#pragma unroll
        for (int r = 0; r < 8; ++r) { qv[r] = bf1(qr[r]); kv[r] = bf1(kr[r]); }
        if (n + 1 < 32) GLA_PREFETCH(n + 1);
        __syncthreads();
        float c[8]; float run = 0.f;
#pragma unroll
        for (int r = 0; r < 8; ++r) { const LAS f32x4* g4 = (const LAS f32x4*)(gfs + (8 * w + r) * 16); float z = gbias;
#pragma unroll
            for (int k4 = 0; k4 < 4; ++k4) { const f32x4 g = g4[k4]; z += g.x * w2r[4 * k4] + g.y * w2r[4 * k4 + 1] + g.z * w2r[4 * k4 + 2] + g.w * w2r[4 * k4 + 3]; }
            const float ls = fminf(z, 0.f) - __logf(1.f + __expf(-fabsf(z)));
            run += ls * (1.f / 16.f); c[r] = run; }
        segtot[w * 64 + d] = run;
        __syncthreads();
        float off = 0.f, tot = 0.f;
#pragma unroll
        for (int s = 0; s < 8; ++s) { const float v = segtot[s * 64 + d]; tot += v; off += (s < w) ? v : 0.f; }
        {
            unsigned kh[4];
#pragma unroll
            for (int r = 0; r < 8; r += 2) {
                const float bc0 = off + c[r], bc1 = off + c[r + 1];
                const float q0 = qv[r] * 0.125f * __expf(bc0), q1 = qv[r + 1] * 0.125f * __expf(bc1);
                const float k0 = kv[r] * __expf(-bc0), k1 = kv[r + 1] * __expf(-bc1);
                Qt[(8 * w + r) * 72 + d] = (bf16_t)(pk2(q0, 0.f) & 0xffffu); Qt[(8 * w + r + 1) * 72 + d] = (bf16_t)(pk2(q1, 0.f) & 0xffffu);
                Kt[(8 * w + r) * 72 + d] = (bf16_t)(pk2(k0, 0.f) & 0xffffu); Kt[(8 * w + r + 1) * 72 + d] = (bf16_t)(pk2(k1, 0.f) & 0xffffu);
                kh[r >> 1] = pk2(kv[r] * __expf(tot - bc0), kv[r + 1] * __expf(tot - bc1)); }
            *(LAS u32x4*)(KhT + d * 72 + 8 * w) = (u32x4){kh[0], kh[1], kh[2], kh[3]};
            if (w == 0) a_s[d] = __expf(tot);
        }
        __syncthreads();
        {
            const int it = w & 3, fr = lane & 15, fq = lane >> 4;
            const bf16x8 a0 = lds_frag(Qt, 16 * it + fr, 8 * fq), a1 = lds_frag(Qt, 16 * it + fr, 32 + 8 * fq);
#pragma unroll
            for (int jj = 0; jj < 2; ++jj) { const int jt = 2 * (w >> 2) + jj;
                f32x4 sc = (f32x4){0.f, 0.f, 0.f, 0.f};
                sc = __builtin_amdgcn_mfma_f32_16x16x32_bf16(a0, lds_frag(Kt, 16 * jt + fr, 8 * fq), sc, 0, 0, 0);
                sc = __builtin_amdgcn_mfma_f32_16x16x32_bf16(a1, lds_frag(Kt, 16 * jt + fr, 32 + 8 * fq), sc, 0, 0, 0);
                const int jcol = 16 * jt + fr;
#pragma unroll
                for (int r = 0; r < 4; ++r) { const int irow = 16 * it + 4 * fq + r; const bool keep = dir ? (irow > jcol) : (irow >= jcol);
                    P[irow * 72 + jcol] = (bf16_t)(pk2(keep ? sc[r] : 0.f, 0.f) & 0xffffu); } }
        }
        __syncthreads();
        {
            const int fr = lane & 15, fq = lane >> 4, ct = w >> 2, xt = w & 3;
            const LAS bf16_t* STc = ST + (n & 1) * 32 * 72; LAS bf16_t* STn = ST + ((n + 1) & 1) * 32 * 72;
            const bf16x8 va0 = lds_frag(vT, 16 * ct + fr, 8 * fq), va1 = lds_frag(vT, 16 * ct + fr, 32 + 8 * fq);
            f32x4 o = (f32x4){0.f, 0.f, 0.f, 0.f};
            o = __builtin_amdgcn_mfma_f32_16x16x32_bf16(va0, lds_frag(P, 16 * xt + fr, 8 * fq), o, 0, 0, 0);
            o = __builtin_amdgcn_mfma_f32_16x16x32_bf16(va1, lds_frag(P, 16 * xt + fr, 32 + 8 * fq), o, 0, 0, 0);
            o = __builtin_amdgcn_mfma_f32_16x16x32_bf16(lds_frag(STc, 16 * ct + fr, 8 * fq), lds_frag(Qt, 16 * xt + fr, 8 * fq), o, 0, 0, 0);
            o = __builtin_amdgcn_mfma_f32_16x16x32_bf16(lds_frag(STc, 16 * ct + fr, 32 + 8 * fq), lds_frag(Qt, 16 * xt + fr, 32 + 8 * fq), o, 0, 0, 0);
            { u32x2 ow; ow.x = pk2(o[0], o[1]); ow.y = pk2(o[2], o[3]);
              *(u32x2*)(obuf + (size_t)GLA_TOK(n, 16 * xt + fr) * 512 + hh * 128 + dvs * 32 + 16 * ct + 4 * fq) = ow; }
            const float av = a_s[16 * xt + fr];
            Sacc = Sacc * av;
            Sacc = __builtin_amdgcn_mfma_f32_16x16x32_bf16(va0, lds_frag(KhT, 16 * xt + fr, 8 * fq), Sacc, 0, 0, 0);
            Sacc = __builtin_amdgcn_mfma_f32_16x16x32_bf16(va1, lds_frag(KhT, 16 * xt + fr, 32 + 8 * fq), Sacc, 0, 0, 0);
#pragma unroll
            for (int r = 0; r < 4; ++r) STn[(16 * ct + 4 * fq + r) * 72 + 16 * xt + fr] = (bf16_t)(pk2(Sacc[r], 0.f) & 0xffffu);
        }
        __syncthreads();
    }
#undef GLA_PREFETCH
#undef GLA_TOK
}

DI void p3_combine(const Params& p, const Ctx& F) {
    const int gw = F.vcu * NWAVES + F.wave, NGW = F.G * NWAVES;
    const bf16_t* of = (const bf16_t*)(p.ws + WS_OFB); const bf16_t* ob = of + (size_t)T * 512;
    const bf16_t* proj = (const bf16_t*)(p.ws + WS_PROJ); bf16_t* cat = (bf16_t*)(p.ws + WS_CAT);
    const float* ng = p.in[8] + (F.lane & 15) * 8;
    const f32x4 g0 = *(const f32x4*)ng, g1 = *(const f32x4*)(ng + 4);
    for (int t = gw; t < T; t += NGW) {
        const u32x4 a = *(const u32x4*)(of + (size_t)t * 512 + 8 * F.lane), bq = *(const u32x4*)(ob + (size_t)t * 512 + 8 * F.lane);
        const u32x4 rr = *(const u32x4*)(proj + (size_t)t * NPROJ + PR + 8 * F.lane);
        float v[8]; float s = 0.f;
#pragma unroll
        for (int j = 0; j < 4; ++j) { v[2 * j] = bflo(a[j]) + bflo(bq[j]); v[2 * j + 1] = bfhi(a[j]) + bfhi(bq[j]); }
#pragma unroll
        for (int j = 0; j < 8; ++j) s += v[j] * v[j];
        s += __shfl_xor(s, 1); s += __shfl_xor(s, 2); s += __shfl_xor(s, 4); s += __shfl_xor(s, 8);
        const float rstd = rsqrtf(s * (1.f / 128.f) + RMS_EPS);
        float o[8];
#pragma unroll
        for (int j = 0; j < 8; ++j) { const float r = (j & 1) ? bfhi(rr[j >> 1]) : bflo(rr[j >> 1]);
            o[j] = v[j] * rstd * (j < 4 ? g0[j & 3] : g1[j & 3]) * (r * __builtin_amdgcn_rcpf(1.f + __expf(-r))); }
        u32x4 w4; w4.x = pk2(o[0], o[1]); w4.y = pk2(o[2], o[3]); w4.z = pk2(o[4], o[5]); w4.w = pk2(o[6], o[7]);
        if (!DBG_GLA) w4 = (u32x4){0u, 0u, 0u, 0u};
#ifdef DBG_SANITIZE
        { bool bad = false; for (int j = 0; j < 8; ++j) bad |= !(fabsf(o[j]) < 1e30f); if (bad) w4 = (u32x4){0u, 0u, 0u, 0u}; }
#endif
        *(u32x4*)(cat + (size_t)t * D + 8 * F.lane) = w4;
    }
}

constexpr int ATT_PITCH = 264;
DI void attn_load_tile(const Ctx& F, LAS bf16_t* dst, const bf16_t* src, int src_pitch) {
    for (int it = F.tid; it < 256 * 32; it += NTHREADS) { const int r = it >> 5, c8 = (it & 31) * 8;
        *(LAS u32x4*)(dst + r * ATT_PITCH + c8) = *(const u32x4*)(src + (size_t)r * src_pitch + c8); }
}
DI void attn_unit(const Params& p, const Ctx& F, int unit) {
    const int b = unit >> 5, hd = (unit >> 3) & 3, qt = unit & 7;
    const bf16_t* q = (const bf16_t*)(p.ws + WS_Q); const bf16_t* kx = (const bf16_t*)(p.ws + WS_KX); const bf16_t* vT = (const bf16_t*)(p.ws + WS_VT);
    bf16_t* ao = (bf16_t*)(p.ws + WS_AO);
    LAS bf16_t* Ts = (LAS bf16_t*)F.lds;
    const int l31 = F.lane & 31, h = F.lane >> 5;
    const int tok = b * SEQ + qt * 256 + F.wave * 32 + l31;
    __syncthreads();
    attn_load_tile(F, Ts, kx + (size_t)(b * MEMLEN) * D + hd * 256, D);
    bf16x8 Bq[16];
#pragma unroll
    for (int s = 0; s < 16; ++s) Bq[s] = *(const bf16x8*)(q + (size_t)tok * D + hd * 256 + 16 * s + 8 * h);
    __syncthreads();
    f32x16 sacc[8];
#pragma unroll
    for (int kt = 0; kt < 8; ++kt) {
        sacc[kt] = ZERO16;
#pragma unroll
        for (int s = 0; s < 16; ++s) { const bf16x8 a = *(const LAS bf16x8*)(Ts + (32 * kt + l31) * ATT_PITCH + 16 * s + 8 * h);
            sacc[kt] = __builtin_amdgcn_mfma_f32_32x32x16_bf16(a, Bq[s], sacc[kt], 0, 0, 0); }
    }
    float mx = -INFINITY;
#pragma unroll
    for (int kt = 0; kt < 8; ++kt)
#pragma unroll
        for (int i = 0; i < 16; ++i) mx = fmaxf(mx, sacc[kt][i]);
    mx = fmaxf(mx, __shfl_xor(mx, 32));
    const float sc = 0.0625f * 1.4426950408889634f; float sum = 0.f;
#pragma unroll
    for (int kt = 0; kt < 8; ++kt)
#pragma unroll
        for (int i = 0; i < 16; ++i) { const float e = __builtin_amdgcn_exp2f((sacc[kt][i] - mx) * sc); sacc[kt][i] = e; sum += e; }
    sum += __shfl_xor(sum, 32);
    const float inv = 1.f / sum;
    bf16x8 Pf[8][2];
#pragma unroll
    for (int kt = 0; kt < 8; ++kt)
#pragma unroll
        for (int s2 = 0; s2 < 2; ++s2) { u32x4 w;
            w.x = pk2(sacc[kt][8 * s2 + 0] * inv, sacc[kt][8 * s2 + 1] * inv); w.y = pk2(sacc[kt][8 * s2 + 2] * inv, sacc[kt][8 * s2 + 3] * inv);
            w.z = pk2(sacc[kt][8 * s2 + 4] * inv, sacc[kt][8 * s2 + 5] * inv); w.w = pk2(sacc[kt][8 * s2 + 6] * inv, sacc[kt][8 * s2 + 7] * inv);
            Pf[kt][s2] = __builtin_bit_cast(bf16x8, w); }
    __syncthreads();
    attn_load_tile(F, Ts, vT + (size_t)(b * D + hd * 256) * 256, 256);
    __syncthreads();
#pragma unroll 1
    for (int dt = 0; dt < 8; ++dt) {
        f32x16 oacc = ZERO16;
#pragma unroll
        for (int kt = 0; kt < 8; ++kt)
#pragma unroll
            for (int s2 = 0; s2 < 2; ++s2) { const LAS bf16_t* vp = Ts + (32 * dt + l31) * ATT_PITCH + 32 * kt + 16 * s2 + 4 * h;
                const u32x2 lo = *(const LAS u32x2*)vp, hi = *(const LAS u32x2*)(vp + 8);
                const bf16x8 a = __builtin_bit_cast(bf16x8, (u32x4){lo.x, lo.y, hi.x, hi.y});
                oacc = __builtin_amdgcn_mfma_f32_32x32x16_bf16(a, Pf[kt][s2], oacc, 0, 0, 0); }
        bf16_t* op = ao + (size_t)tok * D + hd * 256 + 32 * dt + 4 * h;
#pragma unroll
        for (int g = 0; g < 4; ++g) { u32x2 w; w.x = pk2(oacc[4 * g], oacc[4 * g + 1]); w.y = pk2(oacc[4 * g + 2], oacc[4 * g + 3]); *(u32x2*)(op + 8 * g) = w; }
    }
}

DI void moe_tables(const Params& p, const Ctx& F) {
    LAS int* misc = (LAS int*)(F.lds + MISC_OFF);
    __syncthreads();
    if (F.tid == 0) {
        const unsigned* cnt = (const unsigned*)(p.ws + WS_CTL + CTL_CNT);
        int row = 0, mt = 0;
        for (int e = 0; e < NE; ++e) { const int c = (int)__hip_atomic_load(cnt + e, __ATOMIC_RELAXED, __HIP_MEMORY_SCOPE_AGENT); const int nt = (c + 255) >> 8;
            misc[32 + e] = row; for (int i = 0; i < nt; ++i) misc[96 + mt + i] = e; mt += nt; row += nt * 256; }
        misc[32 + NE] = row; misc[16] = mt;
    }
    __syncthreads();
}
DI void p9_scatter(const Params& p, const Ctx& F) {
    const LAS int* misc = (const LAS int*)(F.lds + MISC_OFF);
    const int gw = F.vcu * NWAVES + F.wave, NGW = F.G * NWAVES;
    const bf16_t* x2b = (const bf16_t*)(p.ws + WS_AB); bf16_t* xs = (bf16_t*)(p.ws + WS_XS);
    const int* eidx = (const int*)(p.ws + WS_EIDX); const int* slot = (const int*)(p.ws + WS_SLOT); int* dpos = (int*)(p.ws + WS_DPOS);
    const float* rstd3 = (const float*)(p.ws + WS_RSTD3); float* rsp = (float*)(p.ws + WS_RSP);
    for (int t = gw; t < T; t += NGW) {
        const u32x4* src = (const u32x4*)(x2b + (size_t)t * D) + F.lane;
        const u32x4 v0 = src[0], v1 = src[64];
        const float rs = rstd3[t];
#pragma unroll
        for (int k = 0; k < 4; ++k) { const int e = eidx[t * 4 + k], dest = misc[32 + e] + slot[t * 4 + k];
            u32x4* dst = (u32x4*)(xs + (size_t)dest * D) + F.lane; dst[0] = v0; dst[64] = v1;
            if (F.lane == 0) { rsp[dest] = rs; dpos[t * 4 + k] = dest; } }
    }
}
DI void p12_final(const Params& p, const Ctx& F) {
    const int gw = F.vcu * NWAVES + F.wave, NGW = F.G * NWAVES;
    const bf16_t* ys = (const bf16_t*)(p.ws + WS_YS); const int* dpos = (const int*)(p.ws + WS_DPOS); const float* gate = (const float*)(p.ws + WS_GATE);
    const float* fg = p.in[27];
    for (int t = gw; t < T; t += NGW) {
        f32x4* xr = (f32x4*)(p.out + (size_t)t * D);
        f32x4 v[4];
#pragma unroll
        for (int j = 0; j < 4; ++j) v[j] = xr[64 * j + F.lane];
#pragma unroll
        for (int k = 0; k < (DBG_MOE ? 4 : 0); ++k) { const int dest = dpos[t * 4 + k]; const float g = gate[t * 4 + k];
            const u32x2* yr = (const u32x2*)(ys + (size_t)dest * D);
#pragma unroll
            for (int j = 0; j < 4; ++j) { const u32x2 y = yr[64 * j + F.lane];
                v[j].x += g * bflo(y.x); v[j].y += g * bfhi(y.x); v[j].z += g * bflo(y.y); v[j].w += g * bfhi(y.y); } }
        float s = 0.f;
#pragma unroll
        for (int j = 0; j < 4; ++j) s += (v[j].x * v[j].x + v[j].y * v[j].y) + (v[j].z * v[j].z + v[j].w * v[j].w);
        const float rstd = rsqrtf(wave_sum(s) * (1.f / D) + RMS_EPS);
#pragma unroll
        for (int j = 0; j < 4; ++j) { const f32x4 g = *(const f32x4*)(fg + 4 * (64 * j + F.lane)); xr[64 * j + F.lane] = v[j] * rstd * g; }
    }
}

constexpr int NPHASES = 13;
__global__ void __launch_bounds__(NTHREADS, 2) enc_fwd(Params p) {
    extern __shared__ __attribute__((aligned(16))) unsigned char lds_raw[];
    Ctx F; F.lds = (LAS unsigned char*)lds_raw;
    F.tid = threadIdx.x; F.lane = F.tid & 63; F.wave = __builtin_amdgcn_readfirstlane(F.tid >> 6);
    F.G = gridDim.x; { const int bx = blockIdx.x; F.vcu = (F.G % 8 == 0) ? (bx % 8) * (F.G / 8) + bx / 8 : bx; }
    volatile LAS unsigned* MISC = (volatile LAS unsigned*)(F.lds + MISC_OFF);
    if (F.tid < 4) MISC[F.tid] = 0u;
    __syncthreads();
    const int lo = p.ph_lo, hi = p.ph_hi;
    XcdBarrier bar; bar.bar = (unsigned*)(p.ws + WS_CTL + CTL_BAR); bar.x = 0; bar.st = MISC;
    if (hi - lo > 1) bar = xcd_barrier_post((unsigned*)(p.ws + WS_CTL + CTL_BAR), MISC);
#define IN(k) (lo <= (k) && (k) < hi)
#define SEAM(k) do { if (IN(k) && IN((k) + 1)) xcd_barrier(bar); } while (0)
    unsigned char* ws = p.ws;
    const int cidx = (int)blockIdx.x;

    if (IN(0)) {
        skinny_phase<0>(p, F, p.in[0], p.in[3] + 1536, INW, p.in[2], (bf16_t*)(ws + WS_AB), (float*)(ws + WS_RSTD1));
        __syncthreads();
        p0_mem(p, F);
        p0_weights(p, F);
    }
    SEAM(0);
    if (IN(1)) {
        SchedInKV S{(const char*)(ws + WS_AB), (const char*)(ws + WS_WIN), (const char*)(ws + WS_MEMB), (const char*)(ws + WS_WKV), F.G, cidx};
        EpiInKV E{(bf16_t*)(ws + WS_PROJ), (const float*)(ws + WS_RSTD1), (bf16_t*)(ws + WS_KX), (bf16_t*)(ws + WS_VT), (const float*)(ws + WS_RSTDM)};
        pg8::gemm_phase<EpiInKV, SchedInKV>(F.lds, D, S, E);
    }
    SEAM(1);
    if (IN(2)) {
        for (int tile = F.vcu; tile < T / 64; tile += F.G) conv_tile(p, F, tile);
        for (int u = F.vcu; u < 256; u += F.G) gla_unit(p, F, u);
    }
    SEAM(2);
    if (IN(3)) p3_combine(p, F);
    SEAM(3);
    if (IN(4)) {
        SchedPlain S{(const char*)(ws + WS_CAT), (const char*)(ws + WS_WOUT), F.G, cidx, 4};
        EpiOut E{p.in[0], p.out, (bf16_t*)(ws + WS_AB), (float*)(ws + WS_CTL + CTL_SSQ2)};
        pg8::gemm_phase<EpiOut, SchedPlain>(F.lds, D, S, E);
    }
    SEAM(4);
    if (IN(5)) {
        SchedPlain S{(const char*)(ws + WS_AB), (const char*)(ws + WS_WQ), F.G, cidx, 4};
        EpiQ E{(bf16_t*)(ws + WS_Q), (const float*)(ws + WS_CTL + CTL_SSQ2)};
        pg8::gemm_phase<EpiQ, SchedPlain>(F.lds, D, S, E);
    }
    SEAM(5);
    if (IN(6)) { for (int u = F.vcu; u < 256; u += F.G) attn_unit(p, F, u); }
    SEAM(6);
    if (IN(7)) {
        SchedPlain S{(const char*)(ws + WS_AO), (const char*)(ws + WS_WO), F.G, cidx, 4};
        EpiWo E{p.out};
        pg8::gemm_phase<EpiWo, SchedPlain>(F.lds, D, S, E);
    }
    SEAM(7);
    if (IN(8)) skinny_phase<1>(p, F, p.out, p.in[21], NE, p.in[20], (bf16_t*)(ws + WS_AB), (float*)(ws + WS_RSTD3));
    SEAM(8);
    if (IN(9)) { moe_tables(p, F); p9_scatter(p, F); }
    SEAM(9);
    if (IN(10)) {
        moe_tables(p, F);
        const LAS int* misc = (const LAS int*)(F.lds + MISC_OFF);
        SchedMoE S{(const char*)(ws + WS_XS), (const char*)(ws + WS_WUP), (size_t)2 * FF * D * 2, misc + 96, misc[16], F.G, F.vcu, 8};
        EpiUp E{(bf16_t*)(ws + WS_HID), (const float*)(ws + WS_RSP), p.in[24]};
        pg8::gemm_phase<EpiUp, SchedMoE>(F.lds, D, S, E);
    }
    SEAM(10);
    if (IN(11)) {
        moe_tables(p, F);
        const LAS int* misc = (const LAS int*)(F.lds + MISC_OFF);
        SchedMoE S{(const char*)(ws + WS_HID), (const char*)(ws + WS_WDN), (size_t)D * FF * 2, misc + 96, misc[16], F.G, F.vcu, 4};
        EpiDn E{(bf16_t*)(ws + WS_YS), p.in[26]};
        pg8::gemm_phase<EpiDn, SchedMoE>(F.lds, FF, S, E);
    }
    SEAM(11);
    if (IN(12)) p12_final(p, F);
#undef IN
#undef SEAM
}

#ifndef MK_PER_PHASE
#define MK_PER_PHASE 1
#endif
extern "C" void kernel_launch(void* const* d_in, const int* in_sizes, int n_in, void* d_out, int out_size, void* d_ws, size_t ws_size, hipStream_t stream) {
    static int grid = 0;
    if (grid == 0) {
        if (n_in != 28 || in_sizes[0] != T * D || out_size != T * D || ws_size < WS_END) {
            fprintf(stderr, "kernel_launch: built for 28 inputs, x/out of %d floats, >= %zu bytes of workspace; got n_in %d, in0 %d, out %d, ws %zu\n", T * D, (size_t)WS_END, n_in, n_in > 0 ? in_sizes[0] : -1, out_size, ws_size); grid = -1; return; }
        int dev = 0, cus = 0, per_cu = 0;
        if (hipGetDevice(&dev) != hipSuccess || hipDeviceGetAttribute(&cus, hipDeviceAttributeMultiprocessorCount, dev) != hipSuccess) { grid = -1; return; }
        if (hipFuncSetAttribute((const void*)enc_fwd, hipFuncAttributeMaxDynamicSharedMemorySize, LDS_BYTES) != hipSuccess) { fprintf(stderr, "kernel_launch: hipFuncSetAttribute(%d B LDS) failed\n", LDS_BYTES); grid = -1; return; }
        if (hipOccupancyMaxActiveBlocksPerMultiprocessor(&per_cu, (const void*)enc_fwd, NTHREADS, LDS_BYTES) != hipSuccess || per_cu < 1)
            fprintf(stderr, "kernel_launch: occupancy query reports %d workgroups per CU\n", per_cu);
        (void)hipGetLastError();
        grid = cus;
    }
    if (grid < 0) return;
    if (hipMemsetAsync((char*)d_ws + WS_CTL, 0, CTL_ZERO_BYTES, stream) != hipSuccess) return;
    Params p{};
    for (int i = 0; i < 28; ++i) p.in[i] = (const float*)d_in[i];
    p.out = (float*)d_out; p.ws = (unsigned char*)d_ws;
#if MK_PER_PHASE
    for (int ph = 0; ph < NPHASES; ++ph) { p.ph_lo = ph; p.ph_hi = ph + 1; hipLaunchKernelGGL(enc_fwd, dim3(grid), dim3(NTHREADS), LDS_BYTES, stream, p); }
#else
    p.ph_lo = 0; p.ph_hi = NPHASES; hipLaunchKernelGGL(enc_fwd, dim3(grid), dim3(NTHREADS), LDS_BYTES, stream, p);
#endif
}
```

```cpp
#include <hip/hip_runtime.h>
#include <cstdio>
#include <cstdint>

#define LAS __attribute__((address_space(3)))
typedef unsigned short bf16_t;
typedef short bf16x8 __attribute__((ext_vector_type(8)));
typedef short bf16x4 __attribute__((ext_vector_type(4)));
typedef float f32x4 __attribute__((ext_vector_type(4)));
typedef float f32x2 __attribute__((ext_vector_type(2)));
typedef float f32x16 __attribute__((ext_vector_type(16)));
typedef unsigned u32x4 __attribute__((ext_vector_type(4)));
typedef unsigned u32x2 __attribute__((ext_vector_type(2)));
typedef int i32x4v __attribute__((ext_vector_type(4)));
#define DI __device__ __forceinline__
#ifndef PROBE_DUP_MASK
#define PROBE_DUP_MASK 0
#endif
#define NREP(k) (((PROBE_DUP_MASK >> (k)) & 1) ? 2 : 1)
#ifndef DBG_GLA
#define DBG_GLA 1
#endif
#ifndef DBG_CONV
#define DBG_CONV 1
#endif
#ifndef DBG_MIX
#define DBG_MIX 1
#endif
#ifndef DBG_ATT
#define DBG_ATT 1
#endif
#ifndef DBG_MOE
#define DBG_MOE 1
#endif
#define ZERO16 ((f32x16){0.f, 0.f, 0.f, 0.f, 0.f, 0.f, 0.f, 0.f, 0.f, 0.f, 0.f, 0.f, 0.f, 0.f, 0.f, 0.f})

constexpr int BATCH = 8, SEQ = 2048, D = 1024, T = BATCH * SEQ;
constexpr int MEMLEN = 256, TM = BATCH * MEMLEN;
constexpr int INW = 2592, NPROJ = 2560;
constexpr int PQ = 0, PK = 256, PV = 512, PR = 1024, PGA = 1536, PGG = 2048;
constexpr int NE = 32, TOPK = 4, FF = 1024;
constexpr int MAXROWS = T * TOPK + NE * 256;
constexpr int NWAVES = 8, NTHREADS = 512;
constexpr float RMS_EPS = 1e-6f, LN_EPS = 1e-5f;

typedef __bf16 bf16v2 __attribute__((ext_vector_type(2)));
DI unsigned pk2(float lo, float hi) { f32x2 v = {lo, hi}; bf16v2 b = __builtin_convertvector(v, bf16v2); return __builtin_bit_cast(unsigned, b); }
DI unsigned pk4_fp8(float a, float b, float c, float d) { int w = 0; w = __builtin_amdgcn_cvt_pk_fp8_f32(a, b, w, false); w = __builtin_amdgcn_cvt_pk_fp8_f32(c, d, w, true); return (unsigned)w; }
constexpr float W8_SCALE = 32.f, H8_SCALE = 4.f, AO8_SCALE = 32.f;
DI float bflo(unsigned u) { return __uint_as_float(u << 16); }
DI float bfhi(unsigned u) { return __uint_as_float(u & 0xffff0000u); }
DI float bf1(bf16_t u) { return __uint_as_float(((unsigned)u) << 16); }
DI float wave_sum(float v) {
#pragma unroll
    for (int o = 1; o < 64; o <<= 1) v += __shfl_xor(v, o);
    return v;
}

namespace pg8 {
constexpr int BM = 256, BK = 64, HALF = 128, HTB = HALF * BK * 2, STAGE_BYTES = 8 * HTB;
__host__ __device__ __forceinline__ int lds_byte(int r, int c) { const int st = (r >> 4) * 2 + (c >> 5), rr = r & 15, cc = c & 31, ob = rr * 64 + cc * 2; return st * 1024 + (ob ^ (((ob >> 9) & 1) << 5)); }
__host__ __device__ __forceinline__ void stage_rc(int b, int& R, int& C) { const int st = b / 1024, sb = b % 1024, swz = sb ^ (((sb >> 9) & 1) << 5); R = (st >> 1) * 16 + swz / 64; C = (st & 1) * 32 + (swz % 64) / 2; }
__host__ __device__ __forceinline__ int perm32(int rho) { const int n = rho >> 4, i = rho & 15; return 8 * (i >> 2) + 4 * n + (i & 3); }

struct Unit { int pm, pn, e, ar; };

typedef int i32x8 __attribute__((ext_vector_type(8)));
template <class Epi, class Sched, bool F8 = false>
DI void gemm_phase(LAS unsigned char* lds, const void* base, const int rowbytes, const Sched& S, const Epi& E) {
    const __amdgpu_buffer_rsrc_t rsrc = __builtin_amdgcn_make_buffer_rsrc((void*)base, 0, 0x7fffffff, 0x00020000);
    const int tid = threadIdx.x, wid = __builtin_amdgcn_readfirstlane(tid >> 6), lane = tid & 63, wr = wid >> 2, wc = wid & 3, fr = lane & 15, fq = lane >> 4;
    const int nt = rowbytes / 128;
    unsigned voffA[2], voffB[2];
#pragma unroll
    for (int i = 0; i < 2; ++i) { int R, C; stage_rc(tid * 16 + i * 8192, R, C); const int Rb = Epi::PERM ? ((R & ~31) + perm32(R & 31)) : R;
        voffA[i] = (unsigned)(R * rowbytes + C * 2); voffB[i] = (unsigned)(Rb * rowbytes + C * 2); }
    const unsigned kstep = (unsigned)(BK * 2);
    const unsigned hstep = (unsigned)HALF * (unsigned)rowbytes;
    const unsigned ldsw = (unsigned)wid * 1024u;
    const int aoff = F8 ? lds_byte(wr * 64 + fr, 16 * (fq & 1)) + (fq >> 1) * 1024 : lds_byte(wr * 64 + fr, fq * 8);
    const int boff = F8 ? lds_byte(wc * 32 + fr, 16 * (fq & 1)) + (fq >> 1) * 1024 : lds_byte(wc * 32 + fr, fq * 8);
#define PG8_SA(b, h) (((b) * 2 + (h)) * HTB)
#define PG8_SB(b, h) ((4 + (b) * 2 + (h)) * HTB)
#define PG8_STAGE(bufoff, gbase, voff) do { _Pragma("unroll") for (int _i = 0; _i < 2; ++_i) \
        __builtin_amdgcn_raw_ptr_buffer_load_lds(rsrc, (LAS void*)(lds + (bufoff) + ldsw + _i * 8192), 16, (voff)[_i], (gbase), 0, 0); } while (0)
#define PG8_LDA(dst, b, h) do { _Pragma("unroll") for (int m = 0; m < 4; ++m) _Pragma("unroll") for (int k = 0; k < 2; ++k) dst[m][k] = *(const LAS bf16x8*)(lds + PG8_SA(b, h) + aoff + m * 2048 + k * (F8 ? 16 : 1024)); } while (0)
#define PG8_LDB(dst, b, h) do { _Pragma("unroll") for (int n = 0; n < 2; ++n) _Pragma("unroll") for (int k = 0; k < 2; ++k) dst[n][k] = *(const LAS bf16x8*)(lds + PG8_SB(b, h) + boff + n * 2048 + k * (F8 ? 16 : 1024)); } while (0)
#define PG8_CAT8(x) __builtin_bit_cast(i32x8, __builtin_shufflevector(__builtin_bit_cast(u32x4, (x)[0]), __builtin_bit_cast(u32x4, (x)[1]), 0, 1, 2, 3, 4, 5, 6, 7))
#define PG8_MMA(ai, bj, At, Bt) do { if constexpr (F8) __builtin_amdgcn_sched_barrier(0); __builtin_amdgcn_s_setprio(1); \
        if constexpr (F8) { _Pragma("unroll") for (int m = 0; m < 4; ++m) _Pragma("unroll") for (int n = 0; n < 2; ++n) \
            acc[ai][bj][m][n] = __builtin_amdgcn_mfma_scale_f32_16x16x128_f8f6f4(PG8_CAT8(Bt[n]), PG8_CAT8(At[m]), acc[ai][bj][m][n], 0, 0, 0, 127, 0, 127); } \
        else { _Pragma("unroll") for (int m = 0; m < 4; ++m) _Pragma("unroll") for (int n = 0; n < 2; ++n) _Pragma("unroll") for (int k = 0; k < 2; ++k) \
            acc[ai][bj][m][n] = __builtin_amdgcn_mfma_f32_16x16x32_bf16(Bt[n][k], At[m][k], acc[ai][bj][m][n], 0, 0, 0); } \
        __builtin_amdgcn_s_setprio(0); \
        if constexpr (F8) { _Pragma("unroll") for (int m = 0; m < 4; ++m) _Pragma("unroll") for (int n = 0; n < 2; ++n) asm volatile("" : "+v"(acc[ai][bj][m][n])); __builtin_amdgcn_sched_barrier(0); } } while (0)
#define PG8_WAIT_V(n) asm volatile("s_waitcnt vmcnt(" #n ")" ::: "memory")
#define PG8_WAIT_L(n) asm volatile("s_waitcnt lgkmcnt(" #n ")" ::: "memory")
#define PG8_BAR __builtin_amdgcn_s_barrier()
#define PG8_SCHED __builtin_amdgcn_sched_barrier(0)
    Unit cur, nxt; int ui = 0;
    if (!S.next(0, cur)) return;
    f32x4 acc[2][2][4][2];
#pragma unroll
    for (int a = 0; a < 2; ++a)
#pragma unroll
        for (int b = 0; b < 2; ++b)
#pragma unroll
            for (int m = 0; m < 4; ++m)
#pragma unroll
                for (int n = 0; n < 2; ++n) acc[a][b][m][n] = (f32x4){0.f, 0.f, 0.f, 0.f};
    bf16x8 At[4][2], B0[2][2], B1[2][2];
    unsigned cA = S.aptr(cur), cB = S.bptr(cur);
    PG8_STAGE(PG8_SB(0, 0), cB, voffB); PG8_STAGE(PG8_SB(0, 1), cB + hstep, voffB); PG8_STAGE(PG8_SA(0, 0), cA, voffA); PG8_STAGE(PG8_SA(0, 1), cA + hstep, voffA);
    if (wr == 1) PG8_BAR;
    PG8_WAIT_V(2); PG8_BAR;
    PG8_STAGE(PG8_SB(1, 0), cB + kstep, voffB); PG8_STAGE(PG8_SA(1, 0), cA + kstep, voffA); PG8_STAGE(PG8_SB(1, 1), cB + hstep + kstep, voffB);
    PG8_WAIT_V(6); PG8_BAR;
    for (;;) {
        const bool has_next = S.next(ui + 1, nxt);
        const unsigned nA = has_next ? S.aptr(nxt) : cA, nB = has_next ? S.bptr(nxt) : cB;
        for (int t = 0; t < nt; t += 2) {
            const bool last = (t == nt - 2);
            const unsigned a1 = cA + (unsigned)(t + 1) * kstep;
            const unsigned a2 = last ? nA : cA + (unsigned)(t + 2) * kstep, b2 = last ? nB : cB + (unsigned)(t + 2) * kstep;
            const unsigned a3 = a2 + kstep, b3 = b2 + kstep;
            PG8_LDB(B0, 0, 0); PG8_LDB(B1, 0, 1); PG8_SCHED; PG8_LDA(At, 0, 0); PG8_STAGE(PG8_SA(1, 1), a1 + hstep, voffA);
            PG8_WAIT_V(8); PG8_WAIT_L(0); PG8_BAR; PG8_MMA(0, 0, At, B0); PG8_MMA(0, 1, At, B1); PG8_BAR; PG8_SCHED;
            PG8_LDA(At, 0, 1); PG8_STAGE(PG8_SB(0, 0), b2, voffB); PG8_STAGE(PG8_SB(0, 1), b2 + hstep, voffB); PG8_STAGE(PG8_SA(0, 0), a2, voffA);
            PG8_WAIT_V(8); PG8_WAIT_L(0); PG8_BAR; PG8_MMA(1, 0, At, B0); PG8_MMA(1, 1, At, B1); PG8_BAR; PG8_SCHED;
            PG8_LDB(B0, 1, 0); PG8_LDB(B1, 1, 1); PG8_SCHED; PG8_LDA(At, 1, 0); PG8_STAGE(PG8_SA(0, 1), a2 + hstep, voffA);
            PG8_WAIT_V(8); PG8_WAIT_L(0); PG8_BAR; PG8_MMA(0, 0, At, B0); PG8_MMA(0, 1, At, B1); PG8_BAR; PG8_SCHED;
            PG8_LDA(At, 1, 1); PG8_STAGE(PG8_SB(1, 0), b3, voffB); PG8_STAGE(PG8_SB(1, 1), b3 + hstep, voffB); PG8_STAGE(PG8_SA(1, 0), a3, voffA);
            PG8_WAIT_V(8); PG8_WAIT_L(0); PG8_BAR; PG8_MMA(1, 0, At, B0); PG8_MMA(1, 1, At, B1); PG8_BAR; PG8_SCHED;
        }
        if (wr == 0) PG8_BAR;
        { int ln_ = (int)(threadIdx.x & 63u); asm volatile("" : "+v"(ln_));
          E(acc, cur, wr, wc, ln_ & 15, ln_ >> 4); }
        if (!has_next) break;
#pragma unroll
        for (int a = 0; a < 2; ++a)
#pragma unroll
            for (int b = 0; b < 2; ++b)
#pragma unroll
                for (int m = 0; m < 4; ++m)
#pragma unroll
                    for (int n = 0; n < 2; ++n) acc[a][b][m][n] = (f32x4){0.f, 0.f, 0.f, 0.f};
        cur = nxt; cA = nA; cB = nB; ++ui;
        if (wr == 1) PG8_BAR;
    }
    PG8_WAIT_V(0);
    PG8_BAR;
#undef PG8_SA
#undef PG8_SB
#undef PG8_STAGE
#undef PG8_LDA
#undef PG8_LDB
#undef PG8_MMA
#undef PG8_CAT8
#undef PG8_WAIT_V
#undef PG8_WAIT_L
#undef PG8_BAR
#undef PG8_SCHED
}
}

#define XB_TMO      128
#define XB_XCNT(j)  (256  + 64 * (j))
#define XB_XSUB(j)  (1280 + 64 * (j))
#define XB_XGEN(j)  (2304 + 64 * (j))
#define XB_TOP      3328
#define XB_TOPGEN   3392
#define XCD_BAR_WORDS 3456
#define XB_SPIN_CAP (1u << 18)

__device__ __forceinline__ unsigned xb_ld(unsigned* p)              { return __hip_atomic_load(p, __ATOMIC_RELAXED, __HIP_MEMORY_SCOPE_AGENT); }
__device__ __forceinline__ unsigned xb_add(unsigned* p, unsigned v) { return __hip_atomic_fetch_add(p, v, __ATOMIC_RELAXED, __HIP_MEMORY_SCOPE_AGENT); }
__device__ __forceinline__ unsigned xb_xcc_id() { return (unsigned)__builtin_amdgcn_s_getreg((3 << 11) | 20) & 0xFu; }
#define XB_SPIN(cond, bar) do { unsigned _sp = 0; while (cond) { __builtin_amdgcn_s_sleep(1); \
    if ((++_sp & 255u) == 0u) { if (xb_ld(&(bar)[XB_TMO])) break; if (_sp > XB_SPIN_CAP) { atomicAdd(&(bar)[XB_TMO], 1u); break; } } } } while (0)

struct XcdBarrier { unsigned* bar; unsigned x; volatile LAS unsigned* st; };

__device__ __forceinline__ XcdBarrier xcd_barrier_post(unsigned* bar, volatile LAS unsigned* st) {
    XcdBarrier b; b.bar = bar; b.x = xb_xcc_id(); b.st = st;
    if (threadIdx.x == 0) (void)xb_add(&bar[XB_XCNT(b.x)], 1u);
    return b;
}
__device__ __forceinline__ void xcd_barrier_complete(unsigned* bar, unsigned x, unsigned& nloc, unsigned& nx) {
    const unsigned G = gridDim.x * gridDim.y * gridDim.z;
    unsigned sum, cnt, mine, sp = 0u;
    for (;;) {
        sum = 0u; cnt = 0u; mine = 0u;
#pragma unroll
        for (unsigned j = 0; j < 16; ++j) { const unsigned c = xb_ld(&bar[XB_XCNT(j)]); sum += c; cnt += (c > 0u) ? 1u : 0u; mine = (j == x) ? c : mine; }
        if (sum == G) break;
        __builtin_amdgcn_s_sleep(1);
        if ((++sp & 255u) == 0u) { if (xb_ld(&bar[XB_TMO])) break; if (sp > XB_SPIN_CAP) { atomicAdd(&bar[XB_TMO], 1u); break; } }
    }
    nloc = mine > 0u ? mine : 1u; nx = cnt > 0u ? cnt : 1u;
}
__device__ __forceinline__ void xcd_barrier(const XcdBarrier& b) {
    asm volatile("s_waitcnt vmcnt(0)" ::: "memory");
    __syncthreads();
    if (threadIdx.x == 0) {
        unsigned* bar = b.bar;
        __builtin_amdgcn_s_waitcnt(0);
        unsigned nloc = b.st[0], nx = b.st[1];
        if (nloc == 0u) { xcd_barrier_complete(bar, b.x, nloc, nx); b.st[0] = nloc; b.st[1] = nx; }
        const unsigned old = xb_add(&bar[XB_XSUB(b.x)], 1u);
        const unsigned gen = old / nloc;
        if (old + 1u == (gen + 1u) * nloc) {
            __builtin_amdgcn_fence(__ATOMIC_RELEASE, "agent");
            asm volatile("s_waitcnt vmcnt(0)" ::: "memory");
            const unsigned og = xb_add(&bar[XB_TOP], 1u);
            const unsigned tg = og / nx;
            if (og + 1u == (tg + 1u) * nx) xb_add(&bar[XB_TOPGEN], 1u);
            else XB_SPIN(xb_ld(&bar[XB_TOPGEN]) == tg, bar);
            __builtin_amdgcn_fence(__ATOMIC_ACQUIRE, "agent");
            xb_add(&bar[XB_XGEN(b.x)], 1u);
            asm volatile("s_waitcnt vmcnt(0)" ::: "memory");
        } else {
            XB_SPIN(xb_ld(&bar[XB_XGEN(b.x)]) == gen, bar);
            __builtin_amdgcn_fence(__ATOMIC_ACQUIRE, "agent");
            asm volatile("s_waitcnt vmcnt(0)" ::: "memory");
        }
    }
    __syncthreads();
}

constexpr size_t MiB = 1u << 20;
constexpr size_t WS_CTL = 0, CTL_ZERO_BYTES = 1 * MiB;
constexpr size_t CTL_BAR = 0, CTL_CNT = 16384, CTL_SSQ2 = 65536;
constexpr size_t WS_RSTD1 = 1 * MiB, WS_RSTDM = WS_RSTD1 + 65536, WS_RSTD3 = WS_RSTDM + 65536;
constexpr size_t WS_GRAW = 2 * MiB;
constexpr size_t WS_EIDX = 4 * MiB, WS_SLOT = 5 * MiB, WS_GATE = 6 * MiB, WS_DPOS = 7 * MiB;
constexpr size_t WS_RSP = 8 * MiB;
constexpr size_t WS_WIN = 16 * MiB, WS_WOUT = 22 * MiB, WS_WQ = 24 * MiB, WS_WKV = 26 * MiB, WS_WO = 30 * MiB;
constexpr size_t WS_WUP = 32 * MiB, WS_WDN = 160 * MiB;
constexpr size_t WS_MEMB = 224 * MiB, WS_KX = 228 * MiB, WS_VT = 232 * MiB;
constexpr size_t WS_AB = 236 * MiB;
constexpr size_t WS_PROJ = 268 * MiB;
constexpr size_t WS_OFB = 348 * MiB;
constexpr size_t WS_CAT = 380 * MiB;
constexpr size_t WS_Q = 412 * MiB, WS_AO = 444 * MiB;
constexpr int XCAP = T;
constexpr size_t WS_XS = 268 * MiB;
constexpr size_t WS_HID = 780 * MiB;
constexpr size_t WS_YS = 268 * MiB;
constexpr size_t WS_END = 852 * MiB;
static_assert((size_t)MAXROWS * D * 2 == 144 * MiB, "packed buffers are 144 MiB");

constexpr int LDS_BYTES = 147456, MISC_OFF = LDS_BYTES - 2048;

struct Params {
    const float* in[28]; float* out; unsigned char* ws; int ph_lo, ph_hi;
};

struct Ctx {
    LAS unsigned char* lds; int tid, lane, wave, G, vcu;
};

template <bool F8>
DI void transpose_item(const float* W, int ldw, int ncols, int k0, int n0, const float* scale, void* WTv, int drowA, int drowB, int K, LAS float* scr, int lane) {
    const int kr = lane >> 4, n4 = (lane & 15) * 4;
    f32x4 v[16]; float sc[16];
    const bool ok = (n0 + n4) < ncols;
#pragma unroll
    for (int i = 0; i < 16; ++i) { v[i] = ok ? __builtin_nontemporal_load((const f32x4*)(W + (size_t)(k0 + 4 * i + kr) * ldw + n0 + n4)) : (f32x4){0.f, 0.f, 0.f, 0.f}; sc[i] = (scale ? scale[k0 + 4 * i + kr] : 1.f) * (F8 ? W8_SCALE : 1.f); }
#pragma unroll
    for (int i = 0; i < 16; ++i) { const int k = 4 * i + kr;
        scr[(n4 + 0) * 65 + k] = v[i].x * sc[i]; scr[(n4 + 1) * 65 + k] = v[i].y * sc[i]; scr[(n4 + 2) * 65 + k] = v[i].z * sc[i]; scr[(n4 + 3) * 65 + k] = v[i].w * sc[i]; }
    asm volatile("s_waitcnt lgkmcnt(0)" ::: "memory");
    const int c = lane & 7;
#pragma unroll
    for (int j = 0; j < 8; ++j) { const int n = (lane >> 3) + 8 * j; const LAS float* s = scr + n * 65 + 8 * c;
        const int drow = n < 32 ? drowA + n : drowB + (n - 32); const bool wr_ = (n < 32 ? drowA : drowB) >= 0;
        if constexpr (F8) { u32x2 o; o.x = pk4_fp8(s[0], s[1], s[2], s[3]); o.y = pk4_fp8(s[4], s[5], s[6], s[7]);
            if (wr_) *(u32x2*)((unsigned char*)WTv + (size_t)drow * K + k0 + 8 * c) = o; }
        else { u32x4 o; o.x = pk2(s[0], s[1]); o.y = pk2(s[2], s[3]); o.z = pk2(s[4], s[5]); o.w = pk2(s[6], s[7]);
            if (wr_) *(u32x4*)((bf16_t*)WTv + (size_t)drow * K + k0 + 8 * c) = o; } }
    asm volatile("s_waitcnt lgkmcnt(0)" ::: "memory");
}

DI void p0_weights(const Params& p, const Ctx& F) {
    LAS float* scr = (LAS float*)(F.lds + F.wave * 16640);
    const int gw = F.vcu * NWAVES + F.wave, NGW = F.G * NWAVES;
    unsigned char* ws = p.ws;
    constexpr int I_IN = 16 * 41, I_SQ = 16 * 16, I_UP = 16 * 32 * NE, I_DN = 16 * 16 * NE;
    constexpr int NITEMS = I_IN + 5 * I_SQ + I_UP + I_DN;
    for (int it = gw; it < NITEMS; it += NGW) {
        int r = it;
        if (r < I_IN) { const int kb = r / 41, nb = r % 41, n0 = 64 * nb;
            const int dA = n0 < 1536 ? n0 : (n0 == 1536 ? -1 : n0 - 32), dB = (n0 + 32 >= INW) ? -1 : (n0 + 32 < 1536 ? n0 + 32 : n0);
            transpose_item<false>(p.in[3], INW, INW, 64 * kb, n0, p.in[2], (bf16_t*)(ws + WS_WIN), dA, dB, D, scr, F.lane); continue; }
        r -= I_IN;
        if (r < 5 * I_SQ) { const int m = r / I_SQ, q = r % I_SQ, kb = q / 16, nb = q % 16;
            const float* W = m == 0 ? p.in[13] : m == 1 ? p.in[16] : m == 2 ? p.in[17] : m == 3 ? p.in[18] : p.in[19];
            const float* sc = m == 1 ? p.in[14] : (m == 2 || m == 3) ? p.in[15] : nullptr;
            bf16_t* dst = (bf16_t*)(ws + (m == 0 ? WS_WOUT : m == 1 ? WS_WQ : m == 2 ? WS_WKV : m == 3 ? WS_WKV : WS_WO));
            const int d0 = (m == 3 ? D : 0) + 64 * nb;
            if (m == 1 || m == 4) transpose_item<true>(W, D, D, 64 * kb, 64 * nb, sc, dst, d0, d0 + 32, D, scr, F.lane);
            else transpose_item<false>(W, D, D, 64 * kb, 64 * nb, sc, dst, d0, d0 + 32, D, scr, F.lane);
            continue; }
        r -= 5 * I_SQ;
        if (r < I_UP) { const int e = r / (16 * 32), q = r % (16 * 32), kb = q / 32, nb = q % 32; const int n0 = 64 * nb;
            const int drow = n0 < FF ? (n0 / 128) * 256 + (n0 % 128) : ((n0 - FF) / 128) * 256 + 128 + ((n0 - FF) % 128);
            transpose_item<true>(p.in[23] + (size_t)e * D * 2 * FF, 2 * FF, 2 * FF, 64 * kb, n0, p.in[20], ws + WS_WUP + (size_t)e * 2 * FF * D, drow, drow + 32, D, scr, F.lane); continue; }
        r -= I_UP;
        { const int e = r / (16 * 16), q = r % (16 * 16), kb = q / 16, nb = q % 16;
            transpose_item<true>(p.in[25] + (size_t)e * FF * D, D, D, 64 * kb, 64 * nb, nullptr, ws + WS_WDN + (size_t)e * D * FF, 64 * nb, 64 * nb + 32, FF, scr, F.lane); }
    }
}

DI void p0_mem(const Params& p, const Ctx& F) {
    const int gw = F.vcu * NWAVES + F.wave, NGW = F.G * NWAVES;
    const float* mem = p.in[1]; bf16_t* memb = (bf16_t*)(p.ws + WS_MEMB); float* rstdm = (float*)(p.ws + WS_RSTDM);
    for (int m = gw; m < TM; m += NGW) {
        const f32x4* xr = (const f32x4*)(mem + (size_t)m * D) + F.lane;
        f32x4 v[4]; float s = 0.f;
#pragma unroll
        for (int j = 0; j < 4; ++j) { v[j] = xr[64 * j]; s += (v[j].x * v[j].x + v[j].y * v[j].y) + (v[j].z * v[j].z + v[j].w * v[j].w); }
        s = wave_sum(s);
        u32x2* o8 = (u32x2*)(memb + (size_t)m * D) + F.lane;
#pragma unroll
        for (int j = 0; j < 4; ++j) { u32x2 w; w.x = pk2(v[j].x, v[j].y); w.y = pk2(v[j].z, v[j].w); o8[64 * j] = w; }
        if (F.lane == 0) rstdm[m] = rsqrtf(s * (1.f / D) + RMS_EPS);
    }
}

constexpr int WB_PITCH = 1032;
template <int MODE>
DI void skinny_phase(const Params& p, const Ctx& F, const void* Xv, const float* W, int ldw, const float* gain, void* XBv, float* RSTD) {
    const float* X = (const float*)Xv; bf16_t* XB = (bf16_t*)XBv;
    LAS unsigned* WH = (LAS unsigned*)F.lds; LAS unsigned* WL = WH + 32 * (WB_PITCH / 2);
    const int rg = F.wave & 1, kq = F.wave >> 1, l31 = F.lane & 31, h = F.lane >> 5;
    for (int tile = F.vcu; tile < T / 64; tile += F.G) {
        __syncthreads();
#pragma unroll
        for (int hb = 0; hb < 2; ++hb) { f32x4 wa_[4], wb_[4]; f32x2 gv_[4];
#pragma unroll
            for (int i = 0; i < 4; ++i) { const int kp = (F.tid >> 3) + 64 * (hb * 4 + i), n4 = (F.tid & 7) * 4;
                wa_[i] = *(const f32x4*)(W + (size_t)(2 * kp) * ldw + n4); wb_[i] = *(const f32x4*)(W + (size_t)(2 * kp + 1) * ldw + n4); gv_[i] = *(const f32x2*)(gain + 2 * kp); }
#pragma unroll
            for (int i = 0; i < 4; ++i) { const int kp = (F.tid >> 3) + 64 * (hb * 4 + i), n4 = (F.tid & 7) * 4;
#pragma unroll
                for (int j = 0; j < 4; ++j) { const float a = wa_[i][j] * gv_[i].x, b = wb_[i][j] * gv_[i].y; const unsigned hi = pk2(a, b);
                    WH[(n4 + j) * (WB_PITCH / 2) + kp] = hi; WL[(n4 + j) * (WB_PITCH / 2) + kp] = pk2(a - bflo(hi), b - bfhi(hi)); } } }
        __syncthreads();
        const int row = tile * 64 + rg * 32 + l31;
        const int kbase = kq * 256 + 8 * h;
        const LAS bf16_t* whr = (const LAS bf16_t*)WH + l31 * WB_PITCH + kbase; const LAS bf16_t* wlr = (const LAS bf16_t*)WL + l31 * WB_PITCH + kbase;
        f32x16 acc = ZERO16;
        float ss = 0.f;
#pragma unroll 8
        for (int s16 = 0; s16 < 16; ++s16) { const int k = kbase + 16 * s16;
            const bf16x8 bh = *(const LAS bf16x8*)(whr + 16 * s16), bl = *(const LAS bf16x8*)(wlr + 16 * s16);
            if (MODE == 0) {
                const f32x4 x0 = *(const f32x4*)(X + (size_t)row * D + k), x1 = *(const f32x4*)(X + (size_t)row * D + k + 4);
                ss += (x0.x * x0.x + x0.y * x0.y) + (x0.z * x0.z + x0.w * x0.w) + (x1.x * x1.x + x1.y * x1.y) + (x1.z * x1.z + x1.w * x1.w);
                const u32x4 hi = (u32x4){pk2(x0.x, x0.y), pk2(x0.z, x0.w), pk2(x1.x, x1.y), pk2(x1.z, x1.w)};
                const u32x4 lo = (u32x4){pk2(x0.x - bflo(hi.x), x0.y - bfhi(hi.x)), pk2(x0.z - bflo(hi.y), x0.w - bfhi(hi.y)), pk2(x1.x - bflo(hi.z), x1.y - bfhi(hi.z)), pk2(x1.z - bflo(hi.w), x1.w - bfhi(hi.w))};
                *(u32x4*)(XB + (size_t)row * D + k) = hi;
                acc = __builtin_amdgcn_mfma_f32_32x32x16_bf16(__builtin_bit_cast(bf16x8, hi), bh, acc, 0, 0, 0);
                acc = __builtin_amdgcn_mfma_f32_32x32x16_bf16(__builtin_bit_cast(bf16x8, hi), bl, acc, 0, 0, 0);
                acc = __builtin_amdgcn_mfma_f32_32x32x16_bf16(__builtin_bit_cast(bf16x8, lo), bh, acc, 0, 0, 0);
            } else {
                const u32x4 xb4 = *(const u32x4*)((const bf16_t*)Xv + (size_t)row * D + k);
                float xf[8];
#pragma unroll
                for (int j = 0; j < 4; ++j) { xf[2 * j] = bflo(xb4[j]); xf[2 * j + 1] = bfhi(xb4[j]); }
#pragma unroll
                for (int j = 0; j < 8; ++j) ss += xf[j] * xf[j];
                *(u32x2*)((unsigned char*)XBv + (size_t)row * D + k) = (u32x2){pk4_fp8(xf[0], xf[1], xf[2], xf[3]), pk4_fp8(xf[4], xf[5], xf[6], xf[7])};
                acc = __builtin_amdgcn_mfma_f32_32x32x16_bf16(__builtin_bit_cast(bf16x8, xb4), bh, acc, 0, 0, 0);
                acc = __builtin_amdgcn_mfma_f32_32x32x16_bf16(__builtin_bit_cast(bf16x8, xb4), bl, acc, 0, 0, 0);
            }
        }
        ss += __shfl_xor(ss, 32);
        __syncthreads();
        LAS float* red = (LAS float*)F.lds;
        LAS float* ssq = red + 4 * 64 * 33;
        LAS float* LG = ssq + 4 * 64;
        LAS int* lcnt = (LAS int*)(LG + 64 * 33);
#pragma unroll
        for (int i = 0; i < 16; ++i) { const int rr = rg * 32 + (i & 3) + 8 * (i >> 2) + 4 * h; red[(kq * 64 + rr) * 33 + l31] = acc[i]; }
        if (h == 0) ssq[kq * 64 + rg * 32 + l31] = ss;
        if (MODE == 1 && F.tid < 64) lcnt[F.tid] = 0;
        __syncthreads();
        {
            const int r = F.tid >> 3, n0 = (F.tid & 7) * 4;
            const float s2 = (ssq[r] + ssq[64 + r]) + (ssq[128 + r] + ssq[192 + r]);
            const float rstd = rsqrtf(s2 * (1.f / D) + RMS_EPS);
            float v[4];
#pragma unroll
            for (int i = 0; i < 4; ++i) v[i] = ((red[(0 * 64 + r) * 33 + n0 + i] + red[(1 * 64 + r) * 33 + n0 + i]) + (red[(2 * 64 + r) * 33 + n0 + i] + red[(3 * 64 + r) * 33 + n0 + i])) * rstd;
            const int grow = tile * 64 + r;
            if ((F.tid & 7) == 0) RSTD[grow] = rstd;
            if (MODE == 0) { *(f32x4*)((float*)(p.ws + WS_GRAW) + (size_t)grow * 32 + n0) = (f32x4){v[0], v[1], v[2], v[3]}; }
            else {
#pragma unroll
                for (int i = 0; i < 4; ++i) LG[r * 33 + n0 + i] = v[i] + p.in[22][n0 + i];
            }
        }
        if (MODE == 1) {
            __syncthreads();
            int e4[4]; float g4[4]; int rk[4];
            if (F.tid < 64) {
                float v[32];
#pragma unroll
                for (int n = 0; n < 32; ++n) v[n] = LG[F.tid * 33 + n];
                float tv[4];
#pragma unroll
                for (int k = 0; k < 4; ++k) { float best = -INFINITY; int bi = 0;
#pragma unroll
                    for (int n = 0; n < 32; ++n) { const bool tk = v[n] > best; best = tk ? v[n] : best; bi = tk ? n : bi; }
                    tv[k] = best; e4[k] = bi;
#pragma unroll
                    for (int n = 0; n < 32; ++n) v[n] = (n == bi) ? -INFINITY : v[n]; }
                float den = 0.f;
#pragma unroll
                for (int k = 0; k < 4; ++k) { g4[k] = __expf(tv[k] - tv[0]); den += g4[k]; }
                const float inv = 1.f / den;
#pragma unroll
                for (int k = 0; k < 4; ++k) { g4[k] *= inv; rk[k] = atomicAdd((int*)&lcnt[e4[k]], 1); }
            }
            __syncthreads();
            if (F.tid < 32) { const int c = lcnt[F.tid]; lcnt[32 + F.tid] = c > 0 ? (int)atomicAdd((unsigned*)(p.ws + WS_CTL + CTL_CNT) + F.tid, (unsigned)c) : 0; }
            __syncthreads();
            LAS int* ldest = lcnt + 64;
            if (F.tid < 64) { const int grow = tile * 64 + F.tid;
                int* eidx = (int*)(p.ws + WS_EIDX) + grow * 4; int* slot = (int*)(p.ws + WS_SLOT) + grow * 4; float* gate = (float*)(p.ws + WS_GATE) + grow * 4;
#pragma unroll
                for (int k = 0; k < 4; ++k) { const int sl = lcnt[32 + e4[k]] + rk[k]; eidx[k] = e4[k]; slot[k] = sl; gate[k] = g4[k]; ldest[F.tid * 4 + k] = e4[k] * XCAP + sl; } }
            __syncthreads();
            { const unsigned char* x8 = (const unsigned char*)XBv; unsigned char* xs = p.ws + WS_XS; float* rsp = (float*)(p.ws + WS_RSP);
                u32x4 rv[8]; float rsv[8];
#pragma unroll
                for (int i = 0; i < 8; ++i) { const int grow = tile * 64 + F.wave * 8 + i; rv[i] = *((const u32x4*)(x8 + (size_t)grow * D) + F.lane); rsv[i] = RSTD[grow]; }
#pragma unroll
                for (int i = 0; i < 8; ++i)
#pragma unroll
                    for (int k = 0; k < 4; ++k) { const int dest = ldest[(F.wave * 8 + i) * 4 + k];
                        *((u32x4*)(xs + (size_t)dest * D) + F.lane) = rv[i]; if (F.lane == 0) rsp[dest] = rsv[i]; } }
        }
    }
}

using pg8::Unit;
constexpr size_t PANEL = (size_t)256 * D * 2;
struct SchedInKV {
    unsigned A0, B0, A1, B1; int G, c;
    DI bool next(int i, Unit& u) const {
        const int L = i * G + c; if (L >= 704) return false;
        if (L < 640) { const int x = L & 7, o = L >> 3; u.pm = x * 8 + (o & 7); u.pn = o >> 3; u.e = 0; }
        else { const int j = L - 640; u.pm = j & 7; u.pn = j >> 3; u.e = 1; }
        u.ar = u.pm * 256;
        return true; }
    DI unsigned aptr(const Unit& u) const { return (u.e ? A1 : A0) + (unsigned)u.pm * (unsigned)PANEL; }
    DI unsigned bptr(const Unit& u) const { return (u.e ? B1 : B0) + (unsigned)u.pn * (unsigned)PANEL; }
};
struct SchedPlain {
    unsigned A, B, panel; int G, c, nN;
    DI bool next(int i, Unit& u) const {
        const int L = i * G + c; if (L >= 64 * nN) return false;
        const int x = L & 7, o = L >> 3; u.pm = x * 8 + (o & 7); u.pn = o >> 3; u.e = 0; u.ar = u.pm * 256; return true; }
    DI unsigned aptr(const Unit& u) const { return A + (unsigned)u.pm * panel; }
    DI unsigned bptr(const Unit& u) const { return B + (unsigned)u.pn * panel; }
};
struct SchedMoE {
    unsigned A, B, bstride, panel; const LAS int* tile_e; const LAS int* pstart; int MT, G, vcu, nN; bool sparseA;
    DI bool next(int i, Unit& u) const {
        const int L = i * G + vcu, chunk = L >> 5, j = L & 31;
        int mt, pn; if (nN == 8) { mt = chunk * 4 + (j & 3); pn = j >> 2; } else { mt = chunk * 8 + (j & 7); pn = j >> 3; }
        if (mt >= MT) return false;
        u.pm = mt; u.pn = pn; u.e = tile_e[mt]; u.ar = sparseA ? u.e * XCAP + (mt * 256 - pstart[u.e]) : mt * 256; return true; }
    DI unsigned aptr(const Unit& u) const { return A + (unsigned)u.ar * (panel >> 8); }
    DI unsigned bptr(const Unit& u) const { return B + (unsigned)u.e * bstride + (unsigned)u.pn * panel; }
};

typedef f32x4 AccT[2][2][4][2];
struct EpiInKV {
    static constexpr bool PERM = true;
    bf16_t* proj; const float* rstd1; bf16_t* kx; bf16_t* vT; const float* rstdm;
    DI void operator()(const AccT& acc, const Unit& u, int wr, int wc, int fr, int fq) const {
        const int row0 = u.pm * 256 + wr * 64 + fr;
        if (u.e == 0 || u.pn < 4) {
            bf16_t* base = u.e == 0 ? proj : kx; const int ldc = u.e == 0 ? NPROJ : D; const float* rs_ = u.e == 0 ? rstd1 : rstdm;
            const int col0 = u.pn * 256 + wc * 32 + 8 * fq;
#pragma unroll
            for (int ai = 0; ai < 2; ++ai)
#pragma unroll
                for (int m = 0; m < 4; ++m) { const int row = row0 + ai * 128 + m * 16; const float rs = rs_[row]; bf16_t* rowp = base + (size_t)row * ldc + col0;
#pragma unroll
                    for (int bj = 0; bj < 2; ++bj) { const f32x4 v0 = acc[ai][bj][m][0] * rs, v1 = acc[ai][bj][m][1] * rs;
                        u32x4 w; w.x = pk2(v0[0], v0[1]); w.y = pk2(v0[2], v0[3]); w.z = pk2(v1[0], v1[1]); w.w = pk2(v1[2], v1[3]);
                        *(u32x4*)(rowp + bj * 128) = w; } }
        } else {
            const int d0 = (u.pn - 4) * 256 + wc * 32 + 8 * fq;
#pragma unroll
            for (int ai = 0; ai < 2; ++ai)
#pragma unroll
                for (int m = 0; m < 4; ++m) { const int row = row0 + ai * 128 + m * 16; const float rs = rstdm[row]; const int b = row >> 8, key = row & 255;
#pragma unroll
                    for (int bj = 0; bj < 2; ++bj)
#pragma unroll
                        for (int n = 0; n < 2; ++n)
#pragma unroll
                            for (int i = 0; i < 4; ++i) { const int dc = d0 + bj * 128 + 4 * n + i;
                                vT[((size_t)(b * D + dc)) * 256 + key] = (bf16_t)(pk2(acc[ai][bj][m][n][i] * rs, 0.f) & 0xffffu); } }
        }
    }
};
struct EpiOut {
    static constexpr bool PERM = true;
    bf16_t* xb; unsigned char* x8; unsigned* ssq;
    DI void operator()(const AccT& acc, const Unit& u, int wr, int wc, int fr, int fq) const {
        const int row0 = u.pm * 256 + wr * 64 + fr, col0 = u.pn * 256 + wc * 32 + 8 * fq;
#pragma unroll
        for (int ai = 0; ai < 2; ++ai)
#pragma unroll
            for (int m = 0; m < 4; ++m) { const int row = row0 + ai * 128 + m * 16; const size_t off = (size_t)row * D + col0; float s = 0.f;
#pragma unroll
                for (int bj = 0; bj < 2; ++bj) {
                    const u32x4 xin = *(const u32x4*)(xb + off + bj * 128);
                    const f32x4 zz = (f32x4){0.f, 0.f, 0.f, 0.f};
                    const f32x4 v0 = (DBG_MIX ? acc[ai][bj][m][0] : zz) + (f32x4){bflo(xin.x), bfhi(xin.x), bflo(xin.y), bfhi(xin.y)};
                    const f32x4 v1 = (DBG_MIX ? acc[ai][bj][m][1] : zz) + (f32x4){bflo(xin.z), bfhi(xin.z), bflo(xin.w), bfhi(xin.w)};
                    *(u32x4*)(xb + off + bj * 128) = (u32x4){pk2(v0[0], v0[1]), pk2(v0[2], v0[3]), pk2(v1[0], v1[1]), pk2(v1[2], v1[3])};
                    *(u32x2*)(x8 + off + bj * 128) = (u32x2){pk4_fp8(v0[0], v0[1], v0[2], v0[3]), pk4_fp8(v1[0], v1[1], v1[2], v1[3])};
                    s += (v0[0] * v0[0] + v0[1] * v0[1]) + (v0[2] * v0[2] + v0[3] * v0[3]) + (v1[0] * v1[0] + v1[1] * v1[1]) + (v1[2] * v1[2] + v1[3] * v1[3]); }
                s += __shfl_xor(s, 16); s += __shfl_xor(s, 32);
                if (fq == 0) atomicAdd(ssq + row, (unsigned)(s * 65536.f + 0.5f)); }
    }
};
struct EpiQ {
    static constexpr bool PERM = true;
    bf16_t* q; const unsigned* ssq;
    DI void operator()(const AccT& acc, const Unit& u, int wr, int wc, int fr, int fq) const {
        const int row0 = u.pm * 256 + wr * 64 + fr, col0 = u.pn * 256 + wc * 32 + 8 * fq;
#pragma unroll
        for (int ai = 0; ai < 2; ++ai)
#pragma unroll
            for (int m = 0; m < 4; ++m) { const int row = row0 + ai * 128 + m * 16; const float rs = rsqrtf((float)ssq[row] * (1.f / (65536.f * D)) + RMS_EPS) * (1.f / W8_SCALE); bf16_t* rowp = q + (size_t)row * D + col0;
#pragma unroll
                for (int bj = 0; bj < 2; ++bj) { const f32x4 v0 = acc[ai][bj][m][0] * rs, v1 = acc[ai][bj][m][1] * rs;
                    u32x4 w; w.x = pk2(v0[0], v0[1]); w.y = pk2(v0[2], v0[3]); w.z = pk2(v1[0], v1[1]); w.w = pk2(v1[2], v1[3]);
                    *(u32x4*)(rowp + bj * 128) = w; } }
    }
};
struct EpiWo {
    static constexpr bool PERM = true;
    bf16_t* xb;
    DI void operator()(const AccT& acc, const Unit& u, int wr, int wc, int fr, int fq) const {
        const int row0 = u.pm * 256 + wr * 64 + fr, col0 = u.pn * 256 + wc * 32 + 8 * fq;
        const float sc = 1.f / (W8_SCALE * AO8_SCALE);
#pragma unroll
        for (int ai = 0; ai < 2; ++ai)
#pragma unroll
            for (int m = 0; m < 4; ++m) { bf16_t* rowp = xb + (size_t)(row0 + ai * 128 + m * 16) * D + col0;
#pragma unroll
                for (int bj = 0; bj < 2; ++bj) { u32x4* pp = (u32x4*)(rowp + bj * 128); const u32x4 xin = *pp;
                    if (DBG_ATT) { const f32x4 v0 = acc[ai][bj][m][0] * sc + (f32x4){bflo(xin.x), bfhi(xin.x), bflo(xin.y), bfhi(xin.y)}, v1 = acc[ai][bj][m][1] * sc + (f32x4){bflo(xin.z), bfhi(xin.z), bflo(xin.w), bfhi(xin.w)};
                        *pp = (u32x4){pk2(v0[0], v0[1]), pk2(v0[2], v0[3]), pk2(v1[0], v1[1]), pk2(v1[2], v1[3])}; } } }
    }
};
struct EpiUp {
    static constexpr bool PERM = true;
    unsigned char* hid; const float* rsp; const float* b_up;
    DI void operator()(const AccT& acc, const Unit& u, int wr, int wc, int fr, int fq) const {
        const int row0 = u.pm * 256 + wr * 64 + fr, c0 = u.pn * 128 + wc * 32 + 8 * fq;
        const float* bg = b_up + (size_t)u.e * 2 * FF + c0; const float* bl = bg + FF;
        const f32x4 bg0 = *(const f32x4*)bg, bg1 = *(const f32x4*)(bg + 4), bl0 = *(const f32x4*)bl, bl1 = *(const f32x4*)(bl + 4);
        const f32x2 bgp[4] = {(f32x2){bg0[0], bg0[1]}, (f32x2){bg0[2], bg0[3]}, (f32x2){bg1[0], bg1[1]}, (f32x2){bg1[2], bg1[3]}};
        const f32x2 blp[4] = {(f32x2){bl0[0], bl0[1]}, (f32x2){bl0[2], bl0[3]}, (f32x2){bl1[0], bl1[1]}, (f32x2){bl1[2], bl1[3]}};
        const float KC = -1.702f * 1.4426950408889634f;
#pragma unroll
        for (int ai = 0; ai < 2; ++ai)
#pragma unroll
            for (int m = 0; m < 4; ++m) { const int row = row0 + ai * 128 + m * 16; const float rs = rsp[u.ar + (row - u.pm * 256)] * (1.f / W8_SCALE);
                const f32x2 rs2 = (f32x2){rs, rs};
                unsigned wds[2];
#pragma unroll
                for (int n = 0; n < 2; ++n) { f32x2 hv[2];
#pragma unroll
                    for (int hp = 0; hp < 2; ++hp) {
                        const f32x2 ga = (f32x2){acc[ai][0][m][n][2 * hp], acc[ai][0][m][n][2 * hp + 1]}, la = (f32x2){acc[ai][1][m][n][2 * hp], acc[ai][1][m][n][2 * hp + 1]};
                        f32x2 g = ga * rs2 + bgp[2 * n + hp], l = la * rs2 + blp[2 * n + hp];
                        g.x = fminf(g.x, 7.0f); g.y = fminf(g.y, 7.0f);
                        l.x = __builtin_amdgcn_fmed3f(l.x, -7.0f, 7.0f); l.y = __builtin_amdgcn_fmed3f(l.y, -7.0f, 7.0f);
                        const f32x2 ex = g * KC; f32x2 den; den.x = __builtin_amdgcn_exp2f(ex.x); den.y = __builtin_amdgcn_exp2f(ex.y);
                        den = den + 1.0f; f32x2 sg; sg.x = __builtin_amdgcn_rcpf(den.x); sg.y = __builtin_amdgcn_rcpf(den.y);
                        hv[hp] = (g * sg) * (l * H8_SCALE + H8_SCALE); }
                    wds[n] = pk4_fp8(hv[0].x, hv[0].y, hv[1].x, hv[1].y); }
                *(u32x2*)(hid + (size_t)row * FF + c0) = (u32x2){wds[0], wds[1]}; }
    }
};
struct EpiDn {
    static constexpr bool PERM = true;
    bf16_t* ys; const float* b_dn;
    DI void operator()(const AccT& acc, const Unit& u, int wr, int wc, int fr, int fq) const {
        const int row0 = u.pm * 256 + wr * 64 + fr, col0 = u.pn * 256 + wc * 32 + 8 * fq;
        const float* bb = b_dn + (size_t)u.e * D + col0;
        f32x4 bv[2][2];
#pragma unroll
        for (int bj = 0; bj < 2; ++bj) { bv[bj][0] = *(const f32x4*)(bb + bj * 128); bv[bj][1] = *(const f32x4*)(bb + bj * 128 + 4); }
#pragma unroll
        for (int ai = 0; ai < 2; ++ai)
#pragma unroll
            for (int m = 0; m < 4; ++m) { bf16_t* rowp = ys + (size_t)(row0 + ai * 128 + m * 16) * D + col0;
#pragma unroll
                for (int bj = 0; bj < 2; ++bj) { const f32x4 v0 = acc[ai][bj][m][0] * (1.f / (W8_SCALE * H8_SCALE)) + bv[bj][0], v1 = acc[ai][bj][m][1] * (1.f / (W8_SCALE * H8_SCALE)) + bv[bj][1];
                    u32x4 w; w.x = pk2(v0[0], v0[1]); w.y = pk2(v0[2], v0[3]); w.z = pk2(v1[0], v1[1]); w.w = pk2(v1[2], v1[3]);
                    *(u32x4*)(rowp + bj * 128) = w; } }
    }
};

DI void conv_tile(const Params& p, const Ctx& F, int tile) {
    const bf16_t* proj = (const bf16_t*)(p.ws + WS_PROJ); bf16_t* cat = (bf16_t*)(p.ws + WS_CAT);
    LAS bf16_t* U = (LAS bf16_t*)F.lds;
    const int b = tile >> 5, t0 = (tile & 31) * 64;
    __syncthreads();
    {
        u32x4 av[12], gv[12];
#pragma unroll
        for (int i = 0; i < 12; ++i) { const int it = F.tid + i * NTHREADS, r = it >> 6, c8 = (it & 63) * 8, t = t0 - 15 + r;
            av[i] = (u32x4){0u, 0u, 0u, 0u}; gv[i] = av[i];
            if (it < 94 * 64 && t >= 0 && t < SEQ) { const bf16_t* rowp = proj + (size_t)(b * SEQ + t) * NPROJ; av[i] = *(const u32x4*)(rowp + PGA + c8); gv[i] = *(const u32x4*)(rowp + PGG + c8); } }
#pragma unroll
        for (int i = 0; i < 12; ++i) { const int it = F.tid + i * NTHREADS, r = it >> 6, c8 = (it & 63) * 8;
            u32x4 o;
#pragma unroll
            for (int j = 0; j < 4; ++j) { const float a0 = bflo(av[i][j]), a1 = bfhi(av[i][j]), g0 = bflo(gv[i][j]), g1 = bfhi(gv[i][j]);
                o[j] = pk2(a0 * __builtin_amdgcn_rcpf(1.f + __expf(-g0)), a1 * __builtin_amdgcn_rcpf(1.f + __expf(-g1))); }
            if (it < 94 * 64) *(LAS u32x4*)(U + r * 512 + c8) = o; }
    }
    __syncthreads();
    {
        const int c = F.tid; const float* cw = p.in[9];
        float w[31];
#pragma unroll
        for (int j = 0; j < 31; ++j) w[j] = cw[j * 512 + c];
        const float bias = p.in[10][c];
        float win[31];
#pragma unroll
        for (int r = 0; r < 30; ++r) win[r] = bf1(U[r * 512 + c]);
#pragma unroll
        for (int t = 0; t < 64; ++t) {
            win[(t + 30) % 31] = bf1(U[(t + 30) * 512 + c]);
            float y = bias;
#pragma unroll
            for (int j = 0; j < 31; ++j) y += w[j] * win[(t + j) % 31];
            U[t * 512 + c] = (bf16_t)(pk2(y, 0.f) & 0xffffu);
        }
    }
    __syncthreads();
    {
        const float* lg = p.in[11]; const float* lb = p.in[12];
        const f32x4 g0 = *(const f32x4*)(lg + 8 * F.lane), g1 = *(const f32x4*)(lg + 8 * F.lane + 4), b0 = *(const f32x4*)(lb + 8 * F.lane), b1 = *(const f32x4*)(lb + 8 * F.lane + 4);
        for (int t = F.wave; t < 64; t += NWAVES) {
            const u32x4 raw = *(const LAS u32x4*)(U + t * 512 + 8 * F.lane);
            float v[8];
#pragma unroll
            for (int j = 0; j < 4; ++j) { v[2 * j] = bflo(raw[j]); v[2 * j + 1] = bfhi(raw[j]); }
            float s = 0.f;
#pragma unroll
            for (int j = 0; j < 8; ++j) s += v[j];
            const float mu = wave_sum(s) * (1.f / 512.f); float q = 0.f;
#pragma unroll
            for (int j = 0; j < 8; ++j) { v[j] -= mu; q += v[j] * v[j]; }
            const float rstd = rsqrtf(wave_sum(q) * (1.f / 512.f) + LN_EPS);
            float o[8];
#pragma unroll
            for (int j = 0; j < 8; ++j) { const float y = v[j] * rstd * (j < 4 ? g0[j & 3] : g1[j & 3]) + (j < 4 ? b0[j & 3] : b1[j & 3]); o[j] = y * __builtin_amdgcn_rcpf(1.f + __expf(-y)); }
            u32x4 w4; w4.x = pk2(o[0], o[1]); w4.y = pk2(o[2], o[3]); w4.z = pk2(o[4], o[5]); w4.w = pk2(o[6], o[7]);
            if (!DBG_CONV) w4 = (u32x4){0u, 0u, 0u, 0u};
            *(u32x4*)(cat + (size_t)(b * SEQ + t0 + t) * D + 512 + 8 * F.lane) = w4;
        }
    }
}

constexpr size_t WS_X8 = 348 * MiB;
constexpr size_t WS_X8B = 16 * MiB;
constexpr size_t WS_QT = 412 * MiB, WS_AN = 428 * MiB, WS_SB = 444 * MiB, WS_UB = 476 * MiB;
#define LBAR() do { asm volatile("s_waitcnt lgkmcnt(0)" ::: "memory"); __builtin_amdgcn_s_barrier(); asm volatile("" ::: "memory"); } while (0)
DI bf16x8 lds_frag(const LAS bf16_t* base, int row, int k) { return *(const LAS bf16x8*)(base + row * 72 + k); }
DI int gla_tok(int b, int dir, int pos) { return b * SEQ + (dir ? (SEQ - 1 - pos) : pos); }
constexpr int GLA_STG = 41984;
DI void gla_stage_a(const Params& p, const Ctx& F) {
    const bf16_t* proj = (const bf16_t*)(p.ws + WS_PROJ); const float* graw = (const float*)(p.ws + WS_GRAW);
    bf16_t* oi = (bf16_t*)(p.ws + WS_OFB); bf16_t* qtg = (bf16_t*)(p.ws + WS_QT); float* ang = (float*)(p.ws + WS_AN); bf16_t* ubg = (bf16_t*)(p.ws + WS_UB);
    LAS bf16_t* Qt = (LAS bf16_t*)(F.lds + 2 * GLA_STG);
    LAS bf16_t* Kt = Qt + 64 * 72;
    LAS bf16_t* KhT = Kt + 64 * 72;
    LAS bf16_t* P = KhT + 64 * 72;
    const int w = F.wave, lane = F.lane, fr = lane & 15, g = lane >> 4;
    __syncthreads();
    for (int i = F.tid; i < 2 * GLA_STG / 4; i += NTHREADS) ((LAS unsigned*)F.lds)[i] = 0u;
    const int hf = w >> 2, dt = w & 3;
    u32x4 Lf[2][2];
#pragma unroll
    for (int ii = 0; ii < 2; ++ii)
#pragma unroll
        for (int s2 = 0; s2 < 2; ++s2) { const int irow = 16 * (2 * hf + ii) + fr; unsigned wds[4];
#pragma unroll
            for (int t2 = 0; t2 < 4; ++t2) { const int j0 = 32 * s2 + 16 * ((2 * t2) >> 2) + 4 * g + ((2 * t2) & 3), j1 = j0 + 1;
                wds[t2] = (j0 <= irow ? 0x3F80u : 0u) | (j1 <= irow ? 0x3F800000u : 0u); }
            Lf[ii][s2] = (u32x4){wds[0], wds[1], wds[2], wds[3]}; }
    const u32x4 ones = (u32x4){0x3F803F80u, 0x3F803F80u, 0x3F803F80u, 0x3F803F80u};
    u32x4 qr, kr, vr0, vr1; f32x4 gr = (f32x4){0.f, 0.f, 0.f, 0.f};
    const int sj = F.tid >> 3, sc8 = (F.tid & 7) * 8, sc16 = (F.tid & 7) * 16, gj = F.tid >> 2, gr4 = (F.tid & 3) * 4;
#define GLA_DECODE(it_, b_, h_, d_, n_) const int b_ = (it_) >> 8, h_ = ((it_) >> 6) & 3, d_ = ((it_) >> 5) & 1, n_ = (it_) & 31
#define GLA_PREFETCH(it_) do { GLA_DECODE(it_, pb, ph, pd, pn); \
        const bf16_t* rp = proj + (size_t)gla_tok(pb, pd, pn * 64 + sj) * NPROJ; \
        qr = *(const u32x4*)(rp + PQ + ph * 64 + sc8); kr = *(const u32x4*)(rp + PK + ph * 64 + sc8); \
        vr0 = *(const u32x4*)(rp + PV + ph * 128 + sc16); vr1 = *(const u32x4*)(rp + PV + ph * 128 + sc16 + 8); \
        if (F.tid < 256) gr = *(const f32x4*)(graw + (size_t)gla_tok(pb, pd, pn * 64 + gj) * 32 + pd * 16 + gr4); } while (0)
    int item = F.vcu, cnt = 0;
    if (item < 2048) GLA_PREFETCH(item);
    bf16x8 w2f = (bf16x8){0, 0, 0, 0, 0, 0, 0, 0}; float gbias = 0.f; int w2key = -1;
    __syncthreads();
    for (; item < 2048; item += F.G, ++cnt) {
        GLA_DECODE(item, b, hh, dir, n);
        LAS unsigned char* stg = F.lds + (cnt & 1) * GLA_STG;
        LAS bf16_t* Qr = (LAS bf16_t*)stg; LAS bf16_t* Kr = Qr + 64 * 72; LAS bf16_t* vT = Kr + 64 * 72; LAS bf16_t* GF = vT + 128 * 72;
        *(LAS u32x4*)(Qr + sj * 72 + sc8) = qr; *(LAS u32x4*)(Kr + sj * 72 + sc8) = kr;
#pragma unroll
        for (int i = 0; i < 4; ++i) { vT[(sc16 + 2 * i) * 72 + sj] = (bf16_t)(vr0[i] & 0xffffu); vT[(sc16 + 2 * i + 1) * 72 + sj] = (bf16_t)(vr0[i] >> 16);
            vT[(sc16 + 8 + 2 * i) * 72 + sj] = (bf16_t)(vr1[i] & 0xffffu); vT[(sc16 + 9 + 2 * i) * 72 + sj] = (bf16_t)(vr1[i] >> 16); }
        if (F.tid < 256) { u32x2 o; o.x = pk2(gr.x, gr.y); o.y = pk2(gr.z, gr.w); *(LAS u32x2*)(GF + gj * 40 + gr4) = o; }
        if (item + F.G < 2048) GLA_PREFETCH(item + F.G);
        if (w2key != hh * 2 + dir) { w2key = hh * 2 + dir;
            const float* w2 = p.in[dir ? 6 : 4] + hh * 64 + 16 * dt + fr; float wv[8];
#pragma unroll
            for (int t2 = 0; t2 < 8; ++t2) wv[t2] = g < 2 ? w2[(8 * g + t2) * 256] : 0.f;
            w2f = __builtin_bit_cast(bf16x8, (u32x4){pk2(wv[0], wv[1]), pk2(wv[2], wv[3]), pk2(wv[4], wv[5]), pk2(wv[6], wv[7])});
            gbias = p.in[dir ? 7 : 5][hh * 64 + 16 * dt + fr]; }
        LBAR();
        {
            f32x4 la[4];
#pragma unroll
            for (int jt = 0; jt < 4; ++jt) { const bf16x8 af = *(const LAS bf16x8*)(GF + (16 * jt + fr) * 40 + 8 * g);
                la[jt] = __builtin_amdgcn_mfma_f32_16x16x32_bf16(af, w2f, (f32x4){0.f, 0.f, 0.f, 0.f}, 0, 0, 0);
#pragma unroll
                for (int r = 0; r < 4; ++r) { const float z = la[jt][r] + gbias; la[jt][r] = (fminf(z, 0.f) - __logf(1.f + __expf(-fabsf(z)))) * (1.f / 16.f); } }
            bf16x8 bhi[2], blo[2];
#pragma unroll
            for (int s2 = 0; s2 < 2; ++s2) { float hi[8], lo[8];
#pragma unroll
                for (int t2 = 0; t2 < 8; ++t2) { const float v = la[2 * s2 + (t2 >> 2)][t2 & 3]; const float hv = bflo(pk2(v, 0.f) & 0xffffu); hi[t2] = v; lo[t2] = v - hv; }
                bhi[s2] = __builtin_bit_cast(bf16x8, (u32x4){pk2(hi[0], hi[1]), pk2(hi[2], hi[3]), pk2(hi[4], hi[5]), pk2(hi[6], hi[7])});
                blo[s2] = __builtin_bit_cast(bf16x8, (u32x4){pk2(lo[0], lo[1]), pk2(lo[2], lo[3]), pk2(lo[4], lo[5]), pk2(lo[6], lo[7])}); }
            f32x4 tot = (f32x4){0.f, 0.f, 0.f, 0.f};
#pragma unroll
            for (int s2 = 0; s2 < 2; ++s2) { tot = __builtin_amdgcn_mfma_f32_16x16x32_bf16(__builtin_bit_cast(bf16x8, ones), bhi[s2], tot, 0, 0, 0);
                tot = __builtin_amdgcn_mfma_f32_16x16x32_bf16(__builtin_bit_cast(bf16x8, ones), blo[s2], tot, 0, 0, 0); }
            const float av = __expf(tot[0]);
            const int dcol = 16 * dt + fr;
#pragma unroll
            for (int ii = 0; ii < 2; ++ii) { const int it = 2 * hf + ii;
                f32x4 bc = (f32x4){0.f, 0.f, 0.f, 0.f};
#pragma unroll
                for (int s2 = 0; s2 < 2; ++s2) { bc = __builtin_amdgcn_mfma_f32_16x16x32_bf16(__builtin_bit_cast(bf16x8, Lf[ii][s2]), bhi[s2], bc, 0, 0, 0);
                    bc = __builtin_amdgcn_mfma_f32_16x16x32_bf16(__builtin_bit_cast(bf16x8, Lf[ii][s2]), blo[s2], bc, 0, 0, 0); }
                float kh[4];
#pragma unroll
                for (int r = 0; r < 4; ++r) { const int irow = 16 * it + 4 * g + r; const float e = __expf(bc[r]);
                    const float qv = bf1(Qr[irow * 72 + dcol]), kv = bf1(Kr[irow * 72 + dcol]);
                    const float kt = kv * __builtin_amdgcn_rcpf(e);
                    Qt[irow * 72 + dcol] = (bf16_t)(pk2(qv * 0.125f * e, 0.f) & 0xffffu); Kt[irow * 72 + dcol] = (bf16_t)(pk2(kt, 0.f) & 0xffffu); kh[r] = kt * av; }
                *(LAS u32x2*)(KhT + dcol * 72 + 16 * it + 4 * g) = (u32x2){pk2(kh[0], kh[1]), pk2(kh[2], kh[3])}; }
            if (hf == 0 && g == 0) ang[(size_t)item * 64 + dcol] = av;
        }
        LBAR();
        {
            const int it = w & 3;
            const bf16x8 a0 = lds_frag(Qt, 16 * it + fr, 8 * g), a1 = lds_frag(Qt, 16 * it + fr, 32 + 8 * g);
#pragma unroll
            for (int jj = 0; jj < 2; ++jj) { const int jt = 2 * (w >> 2) + jj;
                f32x4 sc = (f32x4){0.f, 0.f, 0.f, 0.f};
                sc = __builtin_amdgcn_mfma_f32_16x16x32_bf16(a0, lds_frag(Kt, 16 * jt + fr, 8 * g), sc, 0, 0, 0);
                sc = __builtin_amdgcn_mfma_f32_16x16x32_bf16(a1, lds_frag(Kt, 16 * jt + fr, 32 + 8 * g), sc, 0, 0, 0);
                const int jcol = 16 * jt + fr;
#pragma unroll
                for (int r = 0; r < 4; ++r) { const int irow = 16 * it + 4 * g + r; const bool keep = dir ? (irow > jcol) : (irow >= jcol);
                    P[irow * 72 + jcol] = (bf16_t)(pk2(keep ? sc[r] : 0.f, 0.f) & 0xffffu); } }
            *(u32x4*)(qtg + (size_t)item * 4096 + sj * 64 + sc8) = *(const LAS u32x4*)(Qt + sj * 72 + sc8);
        }
        LBAR();
        {
            const int xt = w & 3, ch = w >> 2;
            const bf16x8 p0 = lds_frag(P, 16 * xt + fr, 8 * g), p1 = lds_frag(P, 16 * xt + fr, 32 + 8 * g);
            const bf16x8 k0 = lds_frag(KhT, 16 * xt + fr, 8 * g), k1 = lds_frag(KhT, 16 * xt + fr, 32 + 8 * g);
            bf16_t* orow = oi + (size_t)dir * T * 512 + (size_t)gla_tok(b, dir, n * 64 + 16 * xt + fr) * 512 + hh * 128 + 4 * g;
            bf16_t* urow = ubg + (size_t)item * 8192 + fr * 64 + 16 * xt + 4 * g;
#pragma unroll
            for (int cc = 0; cc < 4; ++cc) { const int ct = 4 * ch + cc;
                const bf16x8 v0 = lds_frag(vT, 16 * ct + fr, 8 * g), v1 = lds_frag(vT, 16 * ct + fr, 32 + 8 * g);
                f32x4 o = (f32x4){0.f, 0.f, 0.f, 0.f}, u = (f32x4){0.f, 0.f, 0.f, 0.f};
                o = __builtin_amdgcn_mfma_f32_16x16x32_bf16(v0, p0, o, 0, 0, 0); o = __builtin_amdgcn_mfma_f32_16x16x32_bf16(v1, p1, o, 0, 0, 0);
                u = __builtin_amdgcn_mfma_f32_16x16x32_bf16(k0, v0, u, 0, 0, 0); u = __builtin_amdgcn_mfma_f32_16x16x32_bf16(k1, v1, u, 0, 0, 0);
                *(u32x2*)(orow + 16 * ct) = (u32x2){pk2(o[0], o[1]), pk2(o[2], o[3])};
                *(u32x2*)(urow + (size_t)(16 * ct) * 64) = (u32x2){pk2(u[0], u[1]), pk2(u[2], u[3])}; }
        }
    }
#undef GLA_PREFETCH
#undef GLA_DECODE
}

DI void gla_stage_b(const Params& p, const Ctx& F) {
    const bf16_t* ubg = (const bf16_t*)(p.ws + WS_UB); const float* ang = (const float*)(p.ws + WS_AN); bf16_t* sbg = (bf16_t*)(p.ws + WS_SB);
    for (int gid = F.vcu * NTHREADS + F.tid; gid < 64 * 2048; gid += F.G * NTHREADS) {
        const int seq = gid >> 11, e4 = (gid & 2047) * 4, d4 = e4 & 63;
        f32x4 S = (f32x4){0.f, 0.f, 0.f, 0.f};
#pragma unroll 8
        for (int n = 0; n < 32; ++n) { const size_t item = (size_t)seq * 32 + n;
            const u32x2 ub = *(const u32x2*)(ubg + item * 8192 + e4); const f32x4 U = (f32x4){bflo(ub.x), bfhi(ub.x), bflo(ub.y), bfhi(ub.y)}, a = *(const f32x4*)(ang + item * 64 + d4);
            *(u32x2*)(sbg + item * 8192 + e4) = (u32x2){pk2(S.x, S.y), pk2(S.z, S.w)};
            S = a * S + U; }
    }
}

DI bf16x8 swz_frag(const LAS bf16_t* base, int row, int q) { return *(const LAS bf16x8*)(base + row * 64 + ((q ^ (row & 7)) << 3)); }
DI void gla_stage_c(const Params& p, const Ctx& F, int tile) {
    const bf16_t* proj = (const bf16_t*)(p.ws + WS_PROJ); const bf16_t* oi = (const bf16_t*)(p.ws + WS_OFB);
    const bf16_t* qtg = (const bf16_t*)(p.ws + WS_QT); const bf16_t* sbg = (const bf16_t*)(p.ws + WS_SB); bf16_t* cat = (bf16_t*)(p.ws + WS_CAT);
    LAS bf16_t* SL = (LAS bf16_t*)F.lds;
    LAS bf16_t* QL = SL + 4 * 8192;
    LAS float* part = (LAS float*)(F.lds + 98304);
    const int b = tile >> 5, n = tile & 31, w = F.wave, fr = F.lane & 15, g = F.lane >> 4, xt = w & 3, ch = w >> 2;
    const int tl = 16 * xt + fr, tok = b * SEQ + n * 64 + tl;
    f32x4 acc[4][4];
    __syncthreads();
#pragma unroll
    for (int rd = 0; rd < 2; ++rd) {
        u32x4 sv[8], qv[4];
#pragma unroll
        for (int i = 0; i < 8; ++i) { const int idx = F.tid + i * NTHREADS, cb = idx >> 10, ck = idx & 1023; const int hh = 2 * rd + (cb >> 1), dir = cb & 1;
            const size_t item = (size_t)(((b * 4 + hh) * 2 + dir) * 32 + (dir ? 31 - n : n));
            sv[i] = *(const u32x4*)(sbg + item * 8192 + ck * 8); }
#pragma unroll
        for (int i = 0; i < 4; ++i) { const int idx = F.tid + i * NTHREADS, cb = idx >> 9, ck = idx & 511; const int hh = 2 * rd + (cb >> 1), dir = cb & 1;
            const size_t item = (size_t)(((b * 4 + hh) * 2 + dir) * 32 + (dir ? 31 - n : n));
            qv[i] = *(const u32x4*)(qtg + item * 4096 + ck * 8); }
#pragma unroll
        for (int h2 = 0; h2 < 2; ++h2) { const int hh = 2 * rd + h2;
#pragma unroll
            for (int cc = 0; cc < 4; ++cc) { const size_t off = (size_t)tok * 512 + hh * 128 + 16 * (4 * ch + cc) + 4 * g;
                const u32x2 f = *(const u32x2*)(oi + off), bk = *(const u32x2*)(oi + (size_t)T * 512 + off);
                acc[hh][cc] = (f32x4){bflo(f.x) + bflo(bk.x), bfhi(f.x) + bfhi(bk.x), bflo(f.y) + bflo(bk.y), bfhi(f.y) + bfhi(bk.y)}; } }
        if (rd) __syncthreads();
#pragma unroll
        for (int i = 0; i < 8; ++i) { const int idx = F.tid + i * NTHREADS, cb = idx >> 10, ck = idx & 1023, r = ck >> 3, q = ck & 7;
            *(LAS u32x4*)(SL + cb * 8192 + r * 64 + ((q ^ (r & 7)) << 3)) = sv[i]; }
#pragma unroll
        for (int i = 0; i < 4; ++i) { const int idx = F.tid + i * NTHREADS, cb = idx >> 9, ck = idx & 511, r = ck >> 3, q = ck & 7;
            *(LAS u32x4*)(QL + cb * 4096 + r * 64 + ((q ^ (r & 7)) << 3)) = qv[i]; }
        __syncthreads();
#pragma unroll
        for (int h2 = 0; h2 < 2; ++h2) { const int hh = 2 * rd + h2;
#pragma unroll
            for (int dir = 0; dir < 2; ++dir) { const int cb = 2 * h2 + dir;
                const int qrow = dir ? 63 - tl : tl;
                const bf16x8 q0 = swz_frag(QL + cb * 4096, qrow, g), q1 = swz_frag(QL + cb * 4096, qrow, 4 + g);
#pragma unroll
                for (int cc = 0; cc < 4; ++cc) { const int crow = 16 * (4 * ch + cc) + fr;
                    acc[hh][cc] = __builtin_amdgcn_mfma_f32_16x16x32_bf16(swz_frag(SL + cb * 8192, crow, g), q0, acc[hh][cc], 0, 0, 0);
                    acc[hh][cc] = __builtin_amdgcn_mfma_f32_16x16x32_bf16(swz_frag(SL + cb * 8192, crow, 4 + g), q1, acc[hh][cc], 0, 0, 0); } }
            float s = 0.f;
#pragma unroll
            for (int cc = 0; cc < 4; ++cc) s += (acc[hh][cc][0] * acc[hh][cc][0] + acc[hh][cc][1] * acc[hh][cc][1]) + (acc[hh][cc][2] * acc[hh][cc][2] + acc[hh][cc][3] * acc[hh][cc][3]);
            s += __shfl_xor(s, 16); s += __shfl_xor(s, 32);
            if (g == 0) part[(hh * 2 + ch) * 64 + tl] = s; }
    }
    __syncthreads();
#pragma unroll
    for (int hh = 0; hh < 4; ++hh) {
        const float rstd = rsqrtf((part[(hh * 2) * 64 + tl] + part[(hh * 2 + 1) * 64 + tl]) * (1.f / 128.f) + RMS_EPS);
#pragma unroll
        for (int cc = 0; cc < 4; ++cc) { const int c = 16 * (4 * ch + cc) + 4 * g;
            const f32x4 ng = *(const f32x4*)(p.in[8] + c);
            const u32x2 rr = *(const u32x2*)(proj + (size_t)tok * NPROJ + PR + hh * 128 + c);
            const float r0 = bflo(rr.x), r1 = bfhi(rr.x), r2 = bflo(rr.y), r3 = bfhi(rr.y);
            const float o0 = acc[hh][cc][0] * rstd * ng[0] * (r0 * __builtin_amdgcn_rcpf(1.f + __expf(-r0))), o1 = acc[hh][cc][1] * rstd * ng[1] * (r1 * __builtin_amdgcn_rcpf(1.f + __expf(-r1)));
            const float o2 = acc[hh][cc][2] * rstd * ng[2] * (r2 * __builtin_amdgcn_rcpf(1.f + __expf(-r2))), o3 = acc[hh][cc][3] * rstd * ng[3] * (r3 * __builtin_amdgcn_rcpf(1.f + __expf(-r3)));
            *(u32x2*)(cat + (size_t)tok * D + hh * 128 + c) = (u32x2){pk2(o0, o1), pk2(o2, o3)}; }
    }
}

constexpr int ATT_PITCH = 264;
DI void attn_load_tile(const Ctx& F, LAS bf16_t* dst, const __amdgpu_buffer_rsrc_t rsrc, unsigned src_off, int src_pitch_bytes) {
    const int r0 = F.tid >> 5, c8 = (F.tid & 31) * 8; const unsigned voff = (unsigned)(r0 * src_pitch_bytes + c8 * 2);
    u32x4 v[16];
#pragma unroll
    for (int i = 0; i < 16; ++i) v[i] = __builtin_amdgcn_raw_buffer_load_b128(rsrc, voff, src_off + (unsigned)(16 * i * src_pitch_bytes), 0);
#pragma unroll
    for (int i = 0; i < 16; ++i) *(LAS u32x4*)(dst + (r0 + 16 * i) * ATT_PITCH + c8) = v[i];
}
DI void attn_unit(const Params& p, const Ctx& F, int unit) {
    const int b = unit >> 5, hd = (unit >> 3) & 3, qt = unit & 7;
    const bf16_t* q = (const bf16_t*)(p.ws + WS_Q); const bf16_t* kx = (const bf16_t*)(p.ws + WS_KX); const bf16_t* vT = (const bf16_t*)(p.ws + WS_VT);
    unsigned char* ao = p.ws + WS_AO;
    LAS bf16_t* Ts = (LAS bf16_t*)F.lds;
    const int l31 = F.lane & 31, h = F.lane >> 5;
    const int tok = b * SEQ + qt * 256 + F.wave * 32 + l31;
    __syncthreads();
    const __amdgpu_buffer_rsrc_t rsrc = __builtin_amdgcn_make_buffer_rsrc((void*)p.ws, 0, 0x7fffffff, 0x00020000);
    attn_load_tile(F, Ts, rsrc, (unsigned)(WS_KX + ((size_t)(b * MEMLEN) * D + hd * 256) * 2), D * 2);
    bf16x8 Bq[16];
#pragma unroll
    for (int s = 0; s < 16; ++s) Bq[s] = *(const bf16x8*)(q + (size_t)tok * D + hd * 256 + 16 * s + 8 * h);
    __syncthreads();
    f32x16 sacc[8];
#pragma unroll
    for (int kt = 0; kt < 8; ++kt) {
#pragma unroll
        for (int s = 0; s < 16; ++s) { const bf16x8 a = *(const LAS bf16x8*)(Ts + (32 * kt + l31) * ATT_PITCH + 16 * s + 8 * h);
            sacc[kt] = __builtin_amdgcn_mfma_f32_32x32x16_bf16(a, Bq[s], s == 0 ? ZERO16 : sacc[kt], 0, 0, 0); }
    }
    float mx = -INFINITY;
#pragma unroll
    for (int kt = 0; kt < 8; ++kt)
#pragma unroll
        for (int i = 0; i < 16; ++i) mx = fmaxf(mx, sacc[kt][i]);
    mx = fmaxf(mx, __shfl_xor(mx, 32));
    const float sc = 0.0625f * 1.4426950408889634f; float sum = 0.f;
#pragma unroll
    for (int kt = 0; kt < 8; ++kt)
#pragma unroll
        for (int i = 0; i < 16; ++i) { const float e = __builtin_amdgcn_exp2f((sacc[kt][i] - mx) * sc); sacc[kt][i] = e; sum += e; }
    sum += __shfl_xor(sum, 32);
    const float inv = 1.f / sum;
    bf16x8 Pf[8][2];
#pragma unroll
    for (int kt = 0; kt < 8; ++kt)
#pragma unroll
        for (int s2 = 0; s2 < 2; ++s2) { u32x4 w;
            w.x = pk2(sacc[kt][8 * s2 + 0] * inv, sacc[kt][8 * s2 + 1] * inv); w.y = pk2(sacc[kt][8 * s2 + 2] * inv, sacc[kt][8 * s2 + 3] * inv);
            w.z = pk2(sacc[kt][8 * s2 + 4] * inv, sacc[kt][8 * s2 + 5] * inv); w.w = pk2(sacc[kt][8 * s2 + 6] * inv, sacc[kt][8 * s2 + 7] * inv);
            Pf[kt][s2] = __builtin_bit_cast(bf16x8, w); }
    __syncthreads();
    attn_load_tile(F, Ts, rsrc, (unsigned)(WS_VT + ((size_t)(b * D + hd * 256) * 256) * 2), 256 * 2);
    __syncthreads();
#pragma unroll 1
    for (int dt = 0; dt < 8; ++dt) {
        f32x16 oacc;
#pragma unroll
        for (int kt = 0; kt < 8; ++kt)
#pragma unroll
            for (int s2 = 0; s2 < 2; ++s2) { const LAS bf16_t* vp = Ts + (32 * dt + l31) * ATT_PITCH + 32 * kt + 16 * s2 + 4 * h;
                const u32x2 lo = *(const LAS u32x2*)vp, hi = *(const LAS u32x2*)(vp + 8);
                const bf16x8 a = __builtin_bit_cast(bf16x8, (u32x4){lo.x, lo.y, hi.x, hi.y});
                oacc = __builtin_amdgcn_mfma_f32_32x32x16_bf16(a, Pf[kt][s2], (kt == 0 && s2 == 0) ? ZERO16 : oacc, 0, 0, 0); }
        unsigned char* op = ao + (size_t)tok * D + hd * 256 + 32 * dt + 4 * h;
#pragma unroll
        for (int g = 0; g < 4; ++g) *(unsigned*)(op + 8 * g) = pk4_fp8(oacc[4 * g] * AO8_SCALE, oacc[4 * g + 1] * AO8_SCALE, oacc[4 * g + 2] * AO8_SCALE, oacc[4 * g + 3] * AO8_SCALE);
    }
}

DI void moe_tables(const Params& p, const Ctx& F) {
    LAS int* misc = (LAS int*)(F.lds + MISC_OFF);
    __syncthreads();
    if (F.tid < NE) misc[400 + F.tid] = (int)__hip_atomic_load((const unsigned*)(p.ws + WS_CTL + CTL_CNT) + F.tid, __ATOMIC_RELAXED, __HIP_MEMORY_SCOPE_AGENT);
    __syncthreads();
    if (F.tid == 0) {
        int row = 0, mt = 0;
        for (int e = 0; e < NE; ++e) { const int c = misc[400 + e]; const int nt = (c + 255) >> 8;
            misc[32 + e] = row; for (int i = 0; i < nt; ++i) misc[96 + mt + i] = e; mt += nt; row += nt * 256; }
        misc[32 + NE] = row; misc[16] = mt;
    }
    __syncthreads();
}
DI void p12_final(const Params& p, const Ctx& F) {
    const int gw = F.vcu * NWAVES + F.wave, NGW = F.G * NWAVES;
    const bf16_t* ys = (const bf16_t*)(p.ws + WS_YS); const int* eidx = (const int*)(p.ws + WS_EIDX); const int* slot = (const int*)(p.ws + WS_SLOT); const float* gate = (const float*)(p.ws + WS_GATE);
    const LAS int* misc = (const LAS int*)(F.lds + MISC_OFF);
    const float* fg = p.in[27];
    f32x4 fgv[4];
#pragma unroll
    for (int j = 0; j < 4; ++j) fgv[j] = *(const f32x4*)(fg + 4 * (64 * j + F.lane));
    for (int t0 = gw; t0 < T; t0 += 2 * NGW) {
        int tt[2]; f32x4 v[2][4]; int dest[2][4]; float gt[2][4];
#pragma unroll
        for (int q = 0; q < 2; ++q) { tt[q] = t0 + q * NGW; if (tt[q] >= T) tt[q] = t0;
            const i32x4v e4 = *(const i32x4v*)(eidx + tt[q] * 4), s4 = *(const i32x4v*)(slot + tt[q] * 4); const f32x4 g4 = *(const f32x4*)(gate + tt[q] * 4);
#pragma unroll
            for (int k = 0; k < 4; ++k) { dest[q][k] = misc[32 + e4[k]] + s4[k]; gt[q][k] = g4[k]; } }
        u32x2 xx[2][4], yy[2][4][4];
#pragma unroll
        for (int q = 0; q < 2; ++q) { const u32x2* x2r = (const u32x2*)((const bf16_t*)(p.ws + WS_AB) + (size_t)tt[q] * D);
#pragma unroll
            for (int j = 0; j < 4; ++j) xx[q][j] = x2r[64 * j + F.lane];
#pragma unroll
            for (int k = 0; k < (DBG_MOE ? 4 : 0); ++k) { const u32x2* yr = (const u32x2*)(ys + (size_t)dest[q][k] * D);
#pragma unroll
                for (int j = 0; j < 4; ++j) yy[q][k][j] = yr[64 * j + F.lane]; } }
#pragma unroll
        for (int q = 0; q < 2; ++q) {
#pragma unroll
            for (int j = 0; j < 4; ++j) v[q][j] = (f32x4){bflo(xx[q][j].x), bfhi(xx[q][j].x), bflo(xx[q][j].y), bfhi(xx[q][j].y)};
#pragma unroll
            for (int k = 0; k < (DBG_MOE ? 4 : 0); ++k) { const float g = gt[q][k];
#pragma unroll
                for (int j = 0; j < 4; ++j) { const u32x2 y = yy[q][k][j];
                    v[q][j].x += g * bflo(y.x); v[q][j].y += g * bfhi(y.x); v[q][j].z += g * bflo(y.y); v[q][j].w += g * bfhi(y.y); } }
            float s = 0.f;
#pragma unroll
            for (int j = 0; j < 4; ++j) s += (v[q][j].x * v[q][j].x + v[q][j].y * v[q][j].y) + (v[q][j].z * v[q][j].z + v[q][j].w * v[q][j].w);
            const float rstd = rsqrtf(wave_sum(s) * (1.f / D) + RMS_EPS);
            if (q == 0 || t0 + NGW < T) { f32x4* xr = (f32x4*)(p.out + (size_t)tt[q] * D);
#pragma unroll
                for (int j = 0; j < 4; ++j) xr[64 * j + F.lane] = v[q][j] * rstd * fgv[j]; } }
    }
}

constexpr int NPHASES = 12;
__global__ void __launch_bounds__(NTHREADS, 2) enc_fwd(Params p) {
    extern __shared__ __attribute__((aligned(16))) unsigned char lds_raw[];
    Ctx F; F.lds = (LAS unsigned char*)lds_raw;
    F.tid = threadIdx.x; F.lane = F.tid & 63; F.wave = __builtin_amdgcn_readfirstlane(F.tid >> 6);
    F.G = gridDim.x; { const int bx = blockIdx.x; F.vcu = (F.G % 8 == 0) ? (bx % 8) * (F.G / 8) + bx / 8 : bx; }
    volatile LAS unsigned* MISC = (volatile LAS unsigned*)(F.lds + MISC_OFF);
    if (F.tid < 4) MISC[F.tid] = 0u;
    __syncthreads();
    const int lo = p.ph_lo, hi = p.ph_hi;
    XcdBarrier bar; bar.bar = (unsigned*)(p.ws + WS_CTL + CTL_BAR); bar.x = 0; bar.st = MISC;
    if (hi - lo > 1) bar = xcd_barrier_post((unsigned*)(p.ws + WS_CTL + CTL_BAR), MISC);
#define IN(k) (lo <= (k) && (k) < hi)
#define SEAM(k) do { if (IN(k) && IN((k) + 1)) xcd_barrier(bar); } while (0)
    unsigned char* ws = p.ws;
    const int cidx = (int)blockIdx.x;

    if (IN(0)) for (int rep = 0; rep < NREP(0); ++rep) {
        if (blockIdx.x & 1) { p0_weights(p, F); p0_mem(p, F); __syncthreads(); skinny_phase<0>(p, F, p.in[0], p.in[3] + 1536, INW, p.in[2], (bf16_t*)(ws + WS_AB), (float*)(ws + WS_RSTD1)); }
        else { skinny_phase<0>(p, F, p.in[0], p.in[3] + 1536, INW, p.in[2], (bf16_t*)(ws + WS_AB), (float*)(ws + WS_RSTD1)); __syncthreads(); p0_mem(p, F); p0_weights(p, F); }
    }
    SEAM(0);
    if (IN(1)) {
        SchedInKV S{(unsigned)WS_AB, (unsigned)WS_WIN, (unsigned)WS_MEMB, (unsigned)WS_WKV, F.G, cidx};
        EpiInKV E{(bf16_t*)(ws + WS_PROJ), (const float*)(ws + WS_RSTD1), (bf16_t*)(ws + WS_KX), (bf16_t*)(ws + WS_VT), (const float*)(ws + WS_RSTDM)};
        pg8::gemm_phase<EpiInKV, SchedInKV>(F.lds, ws, 2 * D, S, E);
    }
    SEAM(1);
    if (IN(2)) for (int rep = 0; rep < NREP(2); ++rep) gla_stage_a(p, F);
    SEAM(2);
    if (IN(3)) for (int rep = 0; rep < NREP(3); ++rep) {
        gla_stage_b(p, F);
        for (int tile = F.vcu; tile < T / 64; tile += F.G) conv_tile(p, F, tile);
    }
    SEAM(3);
    if (IN(4)) for (int rep = 0; rep < NREP(4); ++rep) { for (int tile = F.vcu; tile < T / 64; tile += F.G) gla_stage_c(p, F, tile); }
    SEAM(4);
    if (IN(5)) {
        SchedPlain S{(unsigned)WS_CAT, (unsigned)WS_WOUT, (unsigned)PANEL, F.G, cidx, 4};
        EpiOut E{(bf16_t*)(ws + WS_AB), ws + WS_X8, (unsigned*)(ws + WS_CTL + CTL_SSQ2)};
        pg8::gemm_phase<EpiOut, SchedPlain>(F.lds, ws, 2 * D, S, E);
    }
    SEAM(5);
    if (IN(6)) {
        SchedPlain S{(unsigned)WS_X8, (unsigned)WS_WQ, (unsigned)(256 * D), F.G, cidx, 4};
        EpiQ E{(bf16_t*)(ws + WS_Q), (const unsigned*)(ws + WS_CTL + CTL_SSQ2)};
        pg8::gemm_phase<EpiQ, SchedPlain, true>(F.lds, ws, D, S, E);
        pg8::Unit u;
        for (int i = 0; S.next(i, u); ++i) attn_unit(p, F, ((u.pm >> 3) << 5) | (u.pn << 3) | (u.pm & 7));
    }
    SEAM(6);
    if (IN(7)) {
        SchedPlain S{(unsigned)WS_AO, (unsigned)WS_WO, (unsigned)(256 * D), F.G, cidx, 4};
        EpiWo E{(bf16_t*)(ws + WS_AB)};
        pg8::gemm_phase<EpiWo, SchedPlain, true>(F.lds, ws, D, S, E);
    }
    SEAM(7);
    if (IN(8)) skinny_phase<1>(p, F, ws + WS_AB, p.in[21], NE, p.in[20], ws + WS_X8B, (float*)(ws + WS_RSTD3));
    SEAM(8);
    if (IN(9)) {
        moe_tables(p, F);
        const LAS int* misc = (const LAS int*)(F.lds + MISC_OFF);
        SchedMoE S{(unsigned)WS_XS, (unsigned)WS_WUP, (unsigned)(2 * FF * D), (unsigned)(256 * D), misc + 96, misc + 32, misc[16], F.G, F.vcu, 8, true};
        EpiUp E{ws + WS_HID, (const float*)(ws + WS_RSP), p.in[24]};
        pg8::gemm_phase<EpiUp, SchedMoE, true>(F.lds, ws, D, S, E);
    }
    SEAM(9);
    if (IN(10)) {
        moe_tables(p, F);
        const LAS int* misc = (const LAS int*)(F.lds + MISC_OFF);
        SchedMoE S{(unsigned)WS_HID, (unsigned)WS_WDN, (unsigned)(D * FF), (unsigned)(256 * FF), misc + 96, misc + 32, misc[16], F.G, F.vcu, 4, false};
        EpiDn E{(bf16_t*)(ws + WS_YS), p.in[26]};
        pg8::gemm_phase<EpiDn, SchedMoE, true>(F.lds, ws, FF, S, E);
    }
    SEAM(10);
    if (IN(11)) { moe_tables(p, F); p12_final(p, F); }
#undef IN
#undef SEAM
}

#ifndef MK_PER_PHASE
#define MK_PER_PHASE 0
#endif
extern "C" void kernel_launch(void* const* d_in, const int* in_sizes, int n_in, void* d_out, int out_size, void* d_ws, size_t ws_size, hipStream_t stream) {
    static int grid = 0;
    if (grid == 0) {
        if (n_in != 28 || in_sizes[0] != T * D || out_size != T * D || ws_size < WS_END) {
            fprintf(stderr, "kernel_launch: built for 28 inputs, x/out of %d floats, >= %zu bytes of workspace; got n_in %d, in0 %d, out %d, ws %zu\n", T * D, (size_t)WS_END, n_in, n_in > 0 ? in_sizes[0] : -1, out_size, ws_size); grid = -1; return; }
        int dev = 0, cus = 0, per_cu = 0;
        if (hipGetDevice(&dev) != hipSuccess || hipDeviceGetAttribute(&cus, hipDeviceAttributeMultiprocessorCount, dev) != hipSuccess) { grid = -1; return; }
        if (hipFuncSetAttribute((const void*)enc_fwd, hipFuncAttributeMaxDynamicSharedMemorySize, LDS_BYTES) != hipSuccess) { fprintf(stderr, "kernel_launch: hipFuncSetAttribute(%d B LDS) failed\n", LDS_BYTES); grid = -1; return; }
        if (hipOccupancyMaxActiveBlocksPerMultiprocessor(&per_cu, (const void*)enc_fwd, NTHREADS, LDS_BYTES) != hipSuccess || per_cu < 1)
            fprintf(stderr, "kernel_launch: occupancy query reports %d workgroups per CU\n", per_cu);
        (void)hipGetLastError();
        grid = cus;
    }
    if (grid < 0) return;
    if (hipMemsetAsync((char*)d_ws + WS_CTL, 0, CTL_ZERO_BYTES, stream) != hipSuccess) return;
    Params p{};
    for (int i = 0; i < 28; ++i) p.in[i] = (const float*)d_in[i];
    p.out = (float*)d_out; p.ws = (unsigned char*)d_ws;
#if MK_PER_PHASE
    for (int ph = 0; ph < NPHASES; ++ph) { p.ph_lo = ph; p.ph_hi = ph + 1; hipLaunchKernelGGL(enc_fwd, dim3(grid), dim3(NTHREADS), LDS_BYTES, stream, p); }
#else
    p.ph_lo = 0; p.ph_hi = NPHASES; hipLaunchKernelGGL(enc_fwd, dim3(grid), dim3(NTHREADS), LDS_BYTES, stream, p);
#endif
}
```

```cpp
#include <hip/hip_runtime.h>
#include <cstdio>
#include <cstdint>

#define LAS __attribute__((address_space(3)))
typedef unsigned short bf16_t;
typedef short bf16x8 __attribute__((ext_vector_type(8)));
typedef short bf16x4 __attribute__((ext_vector_type(4)));
typedef float f32x4 __attribute__((ext_vector_type(4)));
typedef float f32x2 __attribute__((ext_vector_type(2)));
typedef float f32x16 __attribute__((ext_vector_type(16)));
typedef unsigned u32x4 __attribute__((ext_vector_type(4)));
typedef unsigned u32x2 __attribute__((ext_vector_type(2)));
typedef int i32x4v __attribute__((ext_vector_type(4)));
#define DI __device__ __forceinline__
#ifndef PROBE_DUP_MASK
#define PROBE_DUP_MASK 0
#endif
#define NREP(k) (((PROBE_DUP_MASK >> (k)) & 1) ? 2 : 1)
#ifndef DBG_GLA
#define DBG_GLA 1
#endif
#ifndef DBG_CONV
#define DBG_CONV 1
#endif
#ifndef DBG_MIX
#define DBG_MIX 1
#endif
#ifndef DBG_ATT
#define DBG_ATT 1
#endif
#ifndef DBG_MOE
#define DBG_MOE 1
#endif
#define ZERO16 ((f32x16){0.f, 0.f, 0.f, 0.f, 0.f, 0.f, 0.f, 0.f, 0.f, 0.f, 0.f, 0.f, 0.f, 0.f, 0.f, 0.f})

constexpr int BATCH = 8, SEQ = 2048, D = 1024, T = BATCH * SEQ;
constexpr int MEMLEN = 256, TM = BATCH * MEMLEN;
constexpr int INW = 2592, NPROJ = 2560;
constexpr int PQ = 0, PK = 256, PV = 512, PR = 1024, PGA = 1536, PGG = 2048;
constexpr int NE = 32, TOPK = 4, FF = 1024;
constexpr int MAXROWS = T * TOPK + NE * 256;
constexpr int NWAVES = 8, NTHREADS = 512;
constexpr float RMS_EPS = 1e-6f, LN_EPS = 1e-5f;

typedef __bf16 bf16v2 __attribute__((ext_vector_type(2)));
DI unsigned pk2(float lo, float hi) { f32x2 v = {lo, hi}; bf16v2 b = __builtin_convertvector(v, bf16v2); return __builtin_bit_cast(unsigned, b); }
DI unsigned pk4_fp8(float a, float b, float c, float d) { int w = 0; w = __builtin_amdgcn_cvt_pk_fp8_f32(a, b, w, false); w = __builtin_amdgcn_cvt_pk_fp8_f32(c, d, w, true); return (unsigned)w; }
constexpr float W8_SCALE = 32.f, H8_SCALE = 4.f, AO8_SCALE = 32.f, YS8_SCALE = 16.f;
DI float bflo(unsigned u) { return __uint_as_float(u << 16); }
DI float bfhi(unsigned u) { return __uint_as_float(u & 0xffff0000u); }
DI float bf1(bf16_t u) { return __uint_as_float(((unsigned)u) << 16); }
DI float wave_sum(float v) {
#pragma unroll
    for (int o = 1; o < 64; o <<= 1) v += __shfl_xor(v, o);
    return v;
}

namespace pg8 {
constexpr int BM = 256, BK = 64, HALF = 128, HTB = HALF * BK * 2, STAGE_BYTES = 8 * HTB;
__host__ __device__ __forceinline__ int lds_byte(int r, int c) { const int st = (r >> 4) * 2 + (c >> 5), rr = r & 15, cc = c & 31, ob = rr * 64 + cc * 2; return st * 1024 + (ob ^ (((ob >> 9) & 1) << 5)); }
__host__ __device__ __forceinline__ void stage_rc(int b, int& R, int& C) { const int st = b / 1024, sb = b % 1024, swz = sb ^ (((sb >> 9) & 1) << 5); R = (st >> 1) * 16 + swz / 64; C = (st & 1) * 32 + (swz % 64) / 2; }
__host__ __device__ __forceinline__ int perm32(int rho) { const int n = rho >> 4, i = rho & 15; return 8 * (i >> 2) + 4 * n + (i & 3); }

struct Unit { int pm, pn, e, ar; };

typedef int i32x8 __attribute__((ext_vector_type(8)));
template <class Epi, class Sched, bool F8 = false>
DI void gemm_phase(LAS unsigned char* lds, const void* base, const int rowbytes, const Sched& S, const Epi& E) {
    const __amdgpu_buffer_rsrc_t rsrc = __builtin_amdgcn_make_buffer_rsrc((void*)base, 0, 0x7fffffff, 0x00020000);
    const int tid = threadIdx.x, wid = __builtin_amdgcn_readfirstlane(tid >> 6), lane = tid & 63, wr = wid >> 2, wc = wid & 3, fr = lane & 15, fq = lane >> 4;
    const int nt = rowbytes / 128;
    unsigned voffA[2], voffB[2];
#pragma unroll
    for (int i = 0; i < 2; ++i) { int R, C; stage_rc(tid * 16 + i * 8192, R, C); const int Rb = Epi::PERM ? ((R & ~31) + perm32(R & 31)) : R;
        voffA[i] = (unsigned)(R * rowbytes + C * 2); voffB[i] = (unsigned)(Rb * rowbytes + C * 2); }
    const unsigned kstep = (unsigned)(BK * 2);
    const unsigned hstep = (unsigned)HALF * (unsigned)rowbytes;
    const unsigned ldsw = (unsigned)wid * 1024u;
    const int aoff = F8 ? lds_byte(wr * 64 + fr, 16 * (fq & 1)) + (fq >> 1) * 1024 : lds_byte(wr * 64 + fr, fq * 8);
    const int boff = F8 ? lds_byte(wc * 32 + fr, 16 * (fq & 1)) + (fq >> 1) * 1024 : lds_byte(wc * 32 + fr, fq * 8);
#define PG8_SA(b, h) (((b) * 2 + (h)) * HTB)
#define PG8_SB(b, h) ((4 + (b) * 2 + (h)) * HTB)
#define PG8_STAGE(bufoff, gbase, voff) do { _Pragma("unroll") for (int _i = 0; _i < 2; ++_i) \
        __builtin_amdgcn_raw_ptr_buffer_load_lds(rsrc, (LAS void*)(lds + (bufoff) + ldsw + _i * 8192), 16, (voff)[_i], (gbase), 0, 0); } while (0)
#define PG8_LDA(dst, b, h) do { _Pragma("unroll") for (int m = 0; m < 4; ++m) _Pragma("unroll") for (int k = 0; k < 2; ++k) dst[m][k] = *(const LAS bf16x8*)(lds + PG8_SA(b, h) + aoff + m * 2048 + k * (F8 ? 16 : 1024)); } while (0)
#define PG8_LDB(dst, b, h) do { _Pragma("unroll") for (int n = 0; n < 2; ++n) _Pragma("unroll") for (int k = 0; k < 2; ++k) dst[n][k] = *(const LAS bf16x8*)(lds + PG8_SB(b, h) + boff + n * 2048 + k * (F8 ? 16 : 1024)); } while (0)
#define PG8_CAT8(x) __builtin_bit_cast(i32x8, __builtin_shufflevector(__builtin_bit_cast(u32x4, (x)[0]), __builtin_bit_cast(u32x4, (x)[1]), 0, 1, 2, 3, 4, 5, 6, 7))
#define PG8_MMA(ai, bj, At, Bt) do { if constexpr (F8) __builtin_amdgcn_sched_barrier(0); __builtin_amdgcn_s_setprio(1); \
        if constexpr (F8) { _Pragma("unroll") for (int m = 0; m < 4; ++m) _Pragma("unroll") for (int n = 0; n < 2; ++n) \
            acc[ai][bj][m][n] = __builtin_amdgcn_mfma_scale_f32_16x16x128_f8f6f4(PG8_CAT8(Bt[n]), PG8_CAT8(At[m]), acc[ai][bj][m][n], 0, 0, 0, 127, 0, 127); } \
        else { _Pragma("unroll") for (int m = 0; m < 4; ++m) _Pragma("unroll") for (int n = 0; n < 2; ++n) _Pragma("unroll") for (int k = 0; k < 2; ++k) \
            acc[ai][bj][m][n] = __builtin_amdgcn_mfma_f32_16x16x32_bf16(Bt[n][k], At[m][k], acc[ai][bj][m][n], 0, 0, 0); } \
        __builtin_amdgcn_s_setprio(0); \
        if constexpr (F8) { _Pragma("unroll") for (int m = 0; m < 4; ++m) _Pragma("unroll") for (int n = 0; n < 2; ++n) asm volatile("" : "+v"(acc[ai][bj][m][n])); __builtin_amdgcn_sched_barrier(0); } } while (0)
#define PG8_WAIT_V(n) asm volatile("s_waitcnt vmcnt(" #n ")" ::: "memory")
#define PG8_WAIT_L(n) asm volatile("s_waitcnt lgkmcnt(" #n ")" ::: "memory")
#define PG8_BAR __builtin_amdgcn_s_barrier()
#define PG8_SCHED __builtin_amdgcn_sched_barrier(0)
    Unit cur, nxt; int ui = 0;
    if (!S.next(0, cur)) return;
    f32x4 acc[2][2][4][2];
#pragma unroll
    for (int a = 0; a < 2; ++a)
#pragma unroll
        for (int b = 0; b < 2; ++b)
#pragma unroll
            for (int m = 0; m < 4; ++m)
#pragma unroll
                for (int n = 0; n < 2; ++n) acc[a][b][m][n] = (f32x4){0.f, 0.f, 0.f, 0.f};
    bf16x8 At[4][2], B0[2][2], B1[2][2];
    unsigned cA = S.aptr(cur), cB = S.bptr(cur);
    PG8_STAGE(PG8_SB(0, 0), cB, voffB); PG8_STAGE(PG8_SB(0, 1), cB + hstep, voffB); PG8_STAGE(PG8_SA(0, 0), cA, voffA); PG8_STAGE(PG8_SA(0, 1), cA + hstep, voffA);
    if (wr == 1) PG8_BAR;
    PG8_WAIT_V(2); PG8_BAR;
    PG8_STAGE(PG8_SB(1, 0), cB + kstep, voffB); PG8_STAGE(PG8_SA(1, 0), cA + kstep, voffA); PG8_STAGE(PG8_SB(1, 1), cB + hstep + kstep, voffB);
    PG8_WAIT_V(6); PG8_BAR;
    for (;;) {
        const bool has_next = S.next(ui + 1, nxt);
        const unsigned nA = has_next ? S.aptr(nxt) : cA, nB = has_next ? S.bptr(nxt) : cB;
        for (int t = 0; t < nt; t += 2) {
            const bool last = (t == nt - 2);
            const unsigned a1 = cA + (unsigned)(t + 1) * kstep;
            const unsigned a2 = last ? nA : cA + (unsigned)(t + 2) * kstep, b2 = last ? nB : cB + (unsigned)(t + 2) * kstep;
            const unsigned a3 = a2 + kstep, b3 = b2 + kstep;
            PG8_LDB(B0, 0, 0); PG8_LDB(B1, 0, 1); PG8_SCHED; PG8_LDA(At, 0, 0); PG8_STAGE(PG8_SA(1, 1), a1 + hstep, voffA);
            PG8_WAIT_V(8); PG8_WAIT_L(0); PG8_BAR; PG8_MMA(0, 0, At, B0); PG8_MMA(0, 1, At, B1); PG8_BAR; PG8_SCHED;
            PG8_LDA(At, 0, 1); PG8_STAGE(PG8_SB(0, 0), b2, voffB); PG8_STAGE(PG8_SB(0, 1), b2 + hstep, voffB); PG8_STAGE(PG8_SA(0, 0), a2, voffA);
            PG8_WAIT_V(8); PG8_WAIT_L(0); PG8_BAR; PG8_MMA(1, 0, At, B0); PG8_MMA(1, 1, At, B1); PG8_BAR; PG8_SCHED;
            PG8_LDB(B0, 1, 0); PG8_LDB(B1, 1, 1); PG8_SCHED; PG8_LDA(At, 1, 0); PG8_STAGE(PG8_SA(0, 1), a2 + hstep, voffA);
            PG8_WAIT_V(8); PG8_WAIT_L(0); PG8_BAR; PG8_MMA(0, 0, At, B0); PG8_MMA(0, 1, At, B1); PG8_BAR; PG8_SCHED;
            PG8_LDA(At, 1, 1); PG8_STAGE(PG8_SB(1, 0), b3, voffB); PG8_STAGE(PG8_SB(1, 1), b3 + hstep, voffB); PG8_STAGE(PG8_SA(1, 0), a3, voffA);
            PG8_WAIT_V(8); PG8_WAIT_L(0); PG8_BAR; PG8_MMA(1, 0, At, B0); PG8_MMA(1, 1, At, B1); PG8_BAR; PG8_SCHED;
        }
        if (wr == 0) PG8_BAR;
        { int ln_ = (int)(threadIdx.x & 63u); asm volatile("" : "+v"(ln_));
          E(acc, cur, wr, wc, ln_ & 15, ln_ >> 4); }
        if (!has_next) break;
#pragma unroll
        for (int a = 0; a < 2; ++a)
#pragma unroll
            for (int b = 0; b < 2; ++b)
#pragma unroll
                for (int m = 0; m < 4; ++m)
#pragma unroll
                    for (int n = 0; n < 2; ++n) acc[a][b][m][n] = (f32x4){0.f, 0.f, 0.f, 0.f};
        cur = nxt; cA = nA; cB = nB; ++ui;
        if (wr == 1) PG8_BAR;
    }
    PG8_WAIT_V(0);
    PG8_BAR;
#undef PG8_SA
#undef PG8_SB
#undef PG8_STAGE
#undef PG8_LDA
#undef PG8_LDB
#undef PG8_MMA
#undef PG8_CAT8
#undef PG8_WAIT_V
#undef PG8_WAIT_L
#undef PG8_BAR
#undef PG8_SCHED
}
}

#define XB_TMO      128
#define XB_XCNT(j)  (256  + 64 * (j))
#define XB_XSUB(j)  (1280 + 64 * (j))
#define XB_XGEN(j)  (2304 + 64 * (j))
#define XB_TOP      3328
#define XB_TOPGEN   3392
#define XCD_BAR_WORDS 3456
#define XB_SPIN_CAP (1u << 18)

__device__ __forceinline__ unsigned xb_ld(unsigned* p)              { return __hip_atomic_load(p, __ATOMIC_RELAXED, __HIP_MEMORY_SCOPE_AGENT); }
__device__ __forceinline__ unsigned xb_add(unsigned* p, unsigned v) { return __hip_atomic_fetch_add(p, v, __ATOMIC_RELAXED, __HIP_MEMORY_SCOPE_AGENT); }
__device__ __forceinline__ unsigned xb_xcc_id() { return (unsigned)__builtin_amdgcn_s_getreg((3 << 11) | 20) & 0xFu; }
#define XB_SPIN(cond, bar) do { unsigned _sp = 0; while (cond) { __builtin_amdgcn_s_sleep(1); \
    if ((++_sp & 255u) == 0u) { if (xb_ld(&(bar)[XB_TMO])) break; if (_sp > XB_SPIN_CAP) { atomicAdd(&(bar)[XB_TMO], 1u); break; } } } } while (0)

struct XcdBarrier { unsigned* bar; unsigned x; volatile LAS unsigned* st; };

__device__ __forceinline__ XcdBarrier xcd_barrier_post(unsigned* bar, volatile LAS unsigned* st) {
    XcdBarrier b; b.bar = bar; b.x = xb_xcc_id(); b.st = st;
    if (threadIdx.x == 0) (void)xb_add(&bar[XB_XCNT(b.x)], 1u);
    return b;
}
__device__ __forceinline__ void xcd_barrier_complete(unsigned* bar, unsigned x, unsigned& nloc, unsigned& nx) {
    const unsigned G = gridDim.x * gridDim.y * gridDim.z;
    unsigned sum, cnt, mine, sp = 0u;
    for (;;) {
        sum = 0u; cnt = 0u; mine = 0u;
#pragma unroll
        for (unsigned j = 0; j < 16; ++j) { const unsigned c = xb_ld(&bar[XB_XCNT(j)]); sum += c; cnt += (c > 0u) ? 1u : 0u; mine = (j == x) ? c : mine; }
        if (sum == G) break;
        __builtin_amdgcn_s_sleep(1);
        if ((++sp & 255u) == 0u) { if (xb_ld(&bar[XB_TMO])) break; if (sp > XB_SPIN_CAP) { atomicAdd(&bar[XB_TMO], 1u); break; } }
    }
    nloc = mine > 0u ? mine : 1u; nx = cnt > 0u ? cnt : 1u;
}
__device__ __forceinline__ void xcd_barrier(const XcdBarrier& b) {
    asm volatile("s_waitcnt vmcnt(0)" ::: "memory");
    __syncthreads();
    if (threadIdx.x == 0) {
        unsigned* bar = b.bar;
        __builtin_amdgcn_s_waitcnt(0);
        unsigned nloc = b.st[0], nx = b.st[1];
        if (nloc == 0u) { xcd_barrier_complete(bar, b.x, nloc, nx); b.st[0] = nloc; b.st[1] = nx; }
        const unsigned old = xb_add(&bar[XB_XSUB(b.x)], 1u);
        const unsigned gen = old / nloc;
        if (old + 1u == (gen + 1u) * nloc) {
            __builtin_amdgcn_fence(__ATOMIC_RELEASE, "agent");
            asm volatile("s_waitcnt vmcnt(0)" ::: "memory");
            const unsigned og = xb_add(&bar[XB_TOP], 1u);
            const unsigned tg = og / nx;
            if (og + 1u == (tg + 1u) * nx) xb_add(&bar[XB_TOPGEN], 1u);
            else XB_SPIN(xb_ld(&bar[XB_TOPGEN]) == tg, bar);
            __builtin_amdgcn_fence(__ATOMIC_ACQUIRE, "agent");
            xb_add(&bar[XB_XGEN(b.x)], 1u);
            asm volatile("s_waitcnt vmcnt(0)" ::: "memory");
        } else {
            XB_SPIN(xb_ld(&bar[XB_XGEN(b.x)]) == gen, bar);
            __builtin_amdgcn_fence(__ATOMIC_ACQUIRE, "agent");
            asm volatile("s_waitcnt vmcnt(0)" ::: "memory");
        }
    }
    __syncthreads();
}

constexpr size_t MiB = 1u << 20;
constexpr size_t WS_CTL = 0, CTL_ZERO_BYTES = 1 * MiB;
constexpr size_t CTL_BAR = 0, CTL_CNT = 16384, CTL_SSQ2 = 65536;
constexpr size_t WS_RSTD1 = 1 * MiB, WS_RSTDM = WS_RSTD1 + 65536, WS_RSTD3 = WS_RSTDM + 65536;
constexpr size_t WS_GRAW = 2 * MiB;
constexpr size_t WS_EIDX = 4 * MiB, WS_SLOT = 5 * MiB, WS_GATE = 6 * MiB, WS_DPOS = 7 * MiB;
constexpr size_t WS_RSP = 8 * MiB;
constexpr size_t WS_WIN = 16 * MiB, WS_WOUT = 22 * MiB, WS_WQ = 24 * MiB, WS_WKV = 26 * MiB, WS_WO = 30 * MiB;
constexpr size_t WS_WUP = 32 * MiB, WS_WDN = 160 * MiB;
constexpr size_t WS_MEMB = 224 * MiB, WS_KX = 228 * MiB, WS_VT = 232 * MiB;
constexpr size_t WS_AB = 236 * MiB;
constexpr size_t WS_PROJ = 268 * MiB;
constexpr size_t WS_OFB = 348 * MiB;
constexpr size_t WS_CAT = 380 * MiB;
constexpr size_t WS_Q = 412 * MiB, WS_AO = 444 * MiB;
constexpr int XCAP = T;
constexpr size_t WS_XS = 268 * MiB;
constexpr size_t WS_HID = 780 * MiB;
constexpr size_t WS_YS = 268 * MiB;
constexpr size_t WS_END = 852 * MiB;
static_assert((size_t)MAXROWS * D * 2 == 144 * MiB, "packed buffers are 144 MiB");

constexpr int LDS_BYTES = 147456, MISC_OFF = LDS_BYTES - 2048;

struct Params {
    const float* in[28]; float* out; unsigned char* ws; int ph_lo, ph_hi;
};

struct Ctx {
    LAS unsigned char* lds; int tid, lane, wave, G, vcu;
};

struct WItem { const float* W; const float* scale; unsigned char* WT; int ldw, ncols, k0, n0, drowA, drowB, f8; };
DI bool p0_decode(const Params& p, int it, WItem& d) {
    unsigned char* ws = p.ws;
    constexpr int I_IN = 16 * 41, I_SQ = 16 * 16, I_UP = 16 * 32 * NE, I_DN = 16 * 16 * NE;
    constexpr int NITEMS = I_IN + 5 * I_SQ + I_UP + I_DN;
    if (it >= NITEMS) return false;
    int r = it;
    if (r < I_IN) { const int kb = r / 41, nb = r % 41, n0 = 64 * nb;
        d.W = p.in[3]; d.scale = p.in[2]; d.WT = ws + WS_WIN; d.ldw = INW; d.ncols = INW; d.k0 = 64 * kb; d.n0 = n0; d.f8 = 0;
        d.drowA = n0 < 1536 ? n0 : (n0 == 1536 ? -1 : n0 - 32); d.drowB = (n0 + 32 >= INW) ? -1 : (n0 + 32 < 1536 ? n0 + 32 : n0); return true; }
    r -= I_IN;
    if (r < 5 * I_SQ) { const int m = r / I_SQ, q = r % I_SQ, kb = q / 16, nb = q % 16;
        if (m == 0) { d.W = p.in[13]; d.scale = nullptr; d.WT = ws + WS_WOUT; d.f8 = 0; }
        else if (m == 1) { d.W = p.in[16]; d.scale = p.in[14]; d.WT = ws + WS_WQ; d.f8 = 1; }
        else if (m == 2) { d.W = p.in[17]; d.scale = p.in[15]; d.WT = ws + WS_WKV; d.f8 = 0; }
        else if (m == 3) { d.W = p.in[18]; d.scale = p.in[15]; d.WT = ws + WS_WKV; d.f8 = 0; }
        else { d.W = p.in[19]; d.scale = nullptr; d.WT = ws + WS_WO; d.f8 = 1; }
        d.ldw = D; d.ncols = D;
        if (d.f8) { const int kb8 = q / 32, nb32 = q % 32; d.k0 = 128 * kb8; d.n0 = 32 * nb32; d.drowA = 32 * nb32; d.drowB = -1; }
        else { d.k0 = 64 * kb; d.n0 = 64 * nb; d.drowA = (m == 3 ? D : 0) + 64 * nb; d.drowB = d.drowA + 32; }
        return true; }
    r -= 5 * I_SQ;
    if (r < I_UP) { const int e = r / (8 * 64), q = r % (8 * 64), kb8 = q / 64, nb32 = q % 64; const int n0 = 32 * nb32;
        d.W = p.in[23] + (size_t)e * D * 2 * FF; d.scale = p.in[20]; d.WT = ws + WS_WUP + (size_t)e * 2 * FF * D; d.ldw = 2 * FF; d.ncols = 2 * FF; d.k0 = 128 * kb8; d.n0 = n0; d.f8 = 1;
        d.drowA = n0 < FF ? (n0 / 128) * 256 + (n0 % 128) : ((n0 - FF) / 128) * 256 + 128 + ((n0 - FF) % 128); d.drowB = -1; return true; }
    r -= I_UP;
    { const int e = r / (8 * 32), q = r % (8 * 32), kb8 = q / 32, nb32 = q % 32;
        d.W = p.in[25] + (size_t)e * FF * D; d.scale = nullptr; d.WT = ws + WS_WDN + (size_t)e * D * FF; d.ldw = D; d.ncols = D; d.k0 = 128 * kb8; d.n0 = 32 * nb32; d.f8 = 1; d.drowA = 32 * nb32; d.drowB = -1; }
    return true;
}
DI void p0_half_load(const WItem& d, int hf, int lane, f32x4 (&v)[8]) {
    if (d.f8) { const int kr = lane >> 3, n4 = (lane & 7) * 4;
        const float* src = d.W + (size_t)(d.k0 + 64 * hf + kr) * d.ldw + d.n0 + n4;
#pragma unroll
        for (int i = 0; i < 8; ++i) v[i] = __builtin_nontemporal_load((const f32x4*)(src + (size_t)(8 * i) * d.ldw));
    } else { const int kr = lane >> 4, n4 = (lane & 15) * 4; const bool ok = (d.n0 + n4) < d.ncols;
        const float* src = d.W + (size_t)(d.k0 + 32 * hf + kr) * d.ldw + d.n0 + n4;
#pragma unroll
        for (int i = 0; i < 8; ++i) v[i] = ok ? __builtin_nontemporal_load((const f32x4*)(src + (size_t)(4 * i) * d.ldw)) : (f32x4){0.f, 0.f, 0.f, 0.f}; }
}
DI void p0_half_lds(const WItem& d, int hf, int lane, const f32x4 (&v)[8], LAS float* scr) {
    if (d.f8) { const int kr = lane >> 3, n4 = (lane & 7) * 4;
#pragma unroll
        for (int i = 0; i < 8; ++i) { const int k = 64 * hf + 8 * i + kr;
            scr[(n4 + 0) * 129 + k] = v[i].x; scr[(n4 + 1) * 129 + k] = v[i].y; scr[(n4 + 2) * 129 + k] = v[i].z; scr[(n4 + 3) * 129 + k] = v[i].w; }
    } else { const int kr = lane >> 4, n4 = (lane & 15) * 4;
#pragma unroll
        for (int i = 0; i < 8; ++i) { const int k = 32 * hf + 4 * i + kr;
            scr[(n4 + 0) * 65 + k] = v[i].x; scr[(n4 + 1) * 65 + k] = v[i].y; scr[(n4 + 2) * 65 + k] = v[i].z; scr[(n4 + 3) * 65 + k] = v[i].w; } }
}
DI void p0_item_store(const WItem& d, int lane, LAS float* scr) {
    const int c = lane & 7;
    if (d.f8) {
        f32x4 g[4];
#pragma unroll
        for (int q = 0; q < 4; ++q) g[q] = d.scale ? *(const f32x4*)(d.scale + d.k0 + 16 * c + 4 * q) * W8_SCALE : (f32x4){W8_SCALE, W8_SCALE, W8_SCALE, W8_SCALE};
        asm volatile("s_waitcnt lgkmcnt(0)" ::: "memory");
#pragma unroll
        for (int j = 0; j < 4; ++j) { const int n = (lane >> 3) + 8 * j; const LAS float* s = scr + n * 129 + 16 * c;
            u32x4 o;
#pragma unroll
            for (int q = 0; q < 4; ++q) o[q] = pk4_fp8(s[4 * q] * g[q][0], s[4 * q + 1] * g[q][1], s[4 * q + 2] * g[q][2], s[4 * q + 3] * g[q][3]);
            *(u32x4*)(d.WT + (size_t)(d.drowA + n) * D + d.k0 + 16 * c) = o; }
    } else {
        f32x4 g0 = (f32x4){1.f, 1.f, 1.f, 1.f}, g1 = g0;
        if (d.scale) { g0 = *(const f32x4*)(d.scale + d.k0 + 8 * c); g1 = *(const f32x4*)(d.scale + d.k0 + 8 * c + 4); }
        asm volatile("s_waitcnt lgkmcnt(0)" ::: "memory");
#pragma unroll
        for (int j = 0; j < 8; ++j) { const int n = (lane >> 3) + 8 * j; const LAS float* s = scr + n * 65 + 8 * c;
            const int drow = n < 32 ? d.drowA + n : d.drowB + (n - 32); const bool wr_ = (n < 32 ? d.drowA : d.drowB) >= 0;
            u32x4 o; o.x = pk2(s[0] * g0[0], s[1] * g0[1]); o.y = pk2(s[2] * g0[2], s[3] * g0[3]); o.z = pk2(s[4] * g1[0], s[5] * g1[1]); o.w = pk2(s[6] * g1[2], s[7] * g1[3]);
            if (wr_) *(u32x4*)((bf16_t*)d.WT + (size_t)drow * D + d.k0 + 8 * c) = o; } }
    asm volatile("s_waitcnt lgkmcnt(0)" ::: "memory");
}
DI void p0_weights(const Params& p, const Ctx& F) {
    LAS float* scr = (LAS float*)(F.lds + F.wave * 16640);
    const int gw = F.vcu * NWAVES + F.wave, NGW = F.G * NWAVES;
    WItem d, dn; f32x4 va[8], vb[8];
    int it = gw;
    bool has = p0_decode(p, it, d);
    if (has) p0_half_load(d, 0, F.lane, va);
    while (has) {
        p0_half_load(d, 1, F.lane, vb);
        p0_half_lds(d, 0, F.lane, va, scr);
        const bool hn = p0_decode(p, it + NGW, dn);
        if (hn) p0_half_load(dn, 0, F.lane, va);
        p0_half_lds(d, 1, F.lane, vb, scr);
        p0_item_store(d, F.lane, scr);
        d = dn; has = hn; it += NGW;
    }
}

DI void p0_mem(const Params& p, const Ctx& F) {
    const int gw = F.vcu * NWAVES + F.wave, NGW = F.G * NWAVES;
    const float* mem = p.in[1]; bf16_t* memb = (bf16_t*)(p.ws + WS_MEMB); float* rstdm = (float*)(p.ws + WS_RSTDM);
    for (int m = gw; m < TM; m += NGW) {
        const f32x4* xr = (const f32x4*)(mem + (size_t)m * D) + F.lane;
        f32x4 v[4]; float s = 0.f;
#pragma unroll
        for (int j = 0; j < 4; ++j) { v[j] = xr[64 * j]; s += (v[j].x * v[j].x + v[j].y * v[j].y) + (v[j].z * v[j].z + v[j].w * v[j].w); }
        s = wave_sum(s);
        u32x2* o8 = (u32x2*)(memb + (size_t)m * D) + F.lane;
#pragma unroll
        for (int j = 0; j < 4; ++j) { u32x2 w; w.x = pk2(v[j].x, v[j].y); w.y = pk2(v[j].z, v[j].w); o8[64 * j] = w; }
        if (F.lane == 0) rstdm[m] = rsqrtf(s * (1.f / D) + RMS_EPS);
    }
}

constexpr int WB_PITCH = 1032;
template <int MODE>
DI void skinny_phase(const Params& p, const Ctx& F, const void* Xv, const float* W, int ldw, const float* gain, void* XBv, float* RSTD) {
    const float* X = (const float*)Xv; bf16_t* XB = (bf16_t*)XBv;
    LAS unsigned* WH = (LAS unsigned*)F.lds; LAS unsigned* WL = WH + 32 * (WB_PITCH / 2);
    const int rg = F.wave & 1, kq = F.wave >> 1, l31 = F.lane & 31, h = F.lane >> 5;
    for (int tile = F.vcu; tile < T / 64; tile += F.G) {
        __syncthreads();
#pragma unroll
        for (int hb = 0; hb < 2; ++hb) { f32x4 wa_[4], wb_[4]; f32x2 gv_[4];
#pragma unroll
            for (int i = 0; i < 4; ++i) { const int kp = (F.tid >> 3) + 64 * (hb * 4 + i), n4 = (F.tid & 7) * 4;
                wa_[i] = *(const f32x4*)(W + (size_t)(2 * kp) * ldw + n4); wb_[i] = *(const f32x4*)(W + (size_t)(2 * kp + 1) * ldw + n4); gv_[i] = *(const f32x2*)(gain + 2 * kp); }
#pragma unroll
            for (int i = 0; i < 4; ++i) { const int kp = (F.tid >> 3) + 64 * (hb * 4 + i), n4 = (F.tid & 7) * 4;
#pragma unroll
                for (int j = 0; j < 4; ++j) { const float a = wa_[i][j] * gv_[i].x, b = wb_[i][j] * gv_[i].y; const unsigned hi = pk2(a, b);
                    WH[(n4 + j) * (WB_PITCH / 2) + kp] = hi; WL[(n4 + j) * (WB_PITCH / 2) + kp] = pk2(a - bflo(hi), b - bfhi(hi)); } } }
        __syncthreads();
        const int row = tile * 64 + rg * 32 + l31;
        const int kbase = kq * 256 + 8 * h;
        const LAS bf16_t* whr = (const LAS bf16_t*)WH + l31 * WB_PITCH + kbase; const LAS bf16_t* wlr = (const LAS bf16_t*)WL + l31 * WB_PITCH + kbase;
        f32x16 acc = ZERO16;
        float ss = 0.f;
#pragma unroll 8
        for (int s16 = 0; s16 < 16; ++s16) { const int k = kbase + 16 * s16;
            const bf16x8 bh = *(const LAS bf16x8*)(whr + 16 * s16), bl = *(const LAS bf16x8*)(wlr + 16 * s16);
            if (MODE == 0) {
                const f32x4 x0 = *(const f32x4*)(X + (size_t)row * D + k), x1 = *(const f32x4*)(X + (size_t)row * D + k + 4);
                ss += (x0.x * x0.x + x0.y * x0.y) + (x0.z * x0.z + x0.w * x0.w) + (x1.x * x1.x + x1.y * x1.y) + (x1.z * x1.z + x1.w * x1.w);
                const u32x4 hi = (u32x4){pk2(x0.x, x0.y), pk2(x0.z, x0.w), pk2(x1.x, x1.y), pk2(x1.z, x1.w)};
                const u32x4 lo = (u32x4){pk2(x0.x - bflo(hi.x), x0.y - bfhi(hi.x)), pk2(x0.z - bflo(hi.y), x0.w - bfhi(hi.y)), pk2(x1.x - bflo(hi.z), x1.y - bfhi(hi.z)), pk2(x1.z - bflo(hi.w), x1.w - bfhi(hi.w))};
                *(u32x4*)(XB + (size_t)row * D + k) = hi;
                acc = __builtin_amdgcn_mfma_f32_32x32x16_bf16(__builtin_bit_cast(bf16x8, hi), bh, acc, 0, 0, 0);
                acc = __builtin_amdgcn_mfma_f32_32x32x16_bf16(__builtin_bit_cast(bf16x8, hi), bl, acc, 0, 0, 0);
                acc = __builtin_amdgcn_mfma_f32_32x32x16_bf16(__builtin_bit_cast(bf16x8, lo), bh, acc, 0, 0, 0);
            } else {
                const u32x4 xb4 = *(const u32x4*)((const bf16_t*)Xv + (size_t)row * D + k);
                float xf[8];
#pragma unroll
                for (int j = 0; j < 4; ++j) { xf[2 * j] = bflo(xb4[j]); xf[2 * j + 1] = bfhi(xb4[j]); }
#pragma unroll
                for (int j = 0; j < 8; ++j) ss += xf[j] * xf[j];
                *(u32x2*)((unsigned char*)XBv + (size_t)row * D + k) = (u32x2){pk4_fp8(xf[0], xf[1], xf[2], xf[3]), pk4_fp8(xf[4], xf[5], xf[6], xf[7])};
                acc = __builtin_amdgcn_mfma_f32_32x32x16_bf16(__builtin_bit_cast(bf16x8, xb4), bh, acc, 0, 0, 0);
                acc = __builtin_amdgcn_mfma_f32_32x32x16_bf16(__builtin_bit_cast(bf16x8, xb4), bl, acc, 0, 0, 0);
            }
        }
        ss += __shfl_xor(ss, 32);
        __syncthreads();
        LAS float* red = (LAS float*)F.lds;
        LAS float* ssq = red + 4 * 64 * 33;
        LAS float* LG = ssq + 4 * 64;
        LAS int* lcnt = (LAS int*)(LG + 64 * 33);
#pragma unroll
        for (int i = 0; i < 16; ++i) { const int rr = rg * 32 + (i & 3) + 8 * (i >> 2) + 4 * h; red[(kq * 64 + rr) * 33 + l31] = acc[i]; }
        if (h == 0) ssq[kq * 64 + rg * 32 + l31] = ss;
        if (MODE == 1 && F.tid < 64) lcnt[F.tid] = 0;
        __syncthreads();
        {
            const int r = F.tid >> 3, n0 = (F.tid & 7) * 4;
            const float s2 = (ssq[r] + ssq[64 + r]) + (ssq[128 + r] + ssq[192 + r]);
            const float rstd = rsqrtf(s2 * (1.f / D) + RMS_EPS);
            float v[4];
#pragma unroll
            for (int i = 0; i < 4; ++i) v[i] = ((red[(0 * 64 + r) * 33 + n0 + i] + red[(1 * 64 + r) * 33 + n0 + i]) + (red[(2 * 64 + r) * 33 + n0 + i] + red[(3 * 64 + r) * 33 + n0 + i])) * rstd;
            const int grow = tile * 64 + r;
            if ((F.tid & 7) == 0) RSTD[grow] = rstd;
            if (MODE == 0) { *(f32x4*)((float*)(p.ws + WS_GRAW) + (size_t)grow * 32 + n0) = (f32x4){v[0], v[1], v[2], v[3]}; }
            else {
#pragma unroll
                for (int i = 0; i < 4; ++i) LG[r * 33 + n0 + i] = v[i] + p.in[22][n0 + i];
            }
        }
        if (MODE == 1) {
            __syncthreads();
            int e4[4]; float g4[4]; int rk[4];
            if (F.tid < 64) {
                float v[32];
#pragma unroll
                for (int n = 0; n < 32; ++n) v[n] = LG[F.tid * 33 + n];
                float tv[4];
#pragma unroll
                for (int k = 0; k < 4; ++k) { float best = -INFINITY; int bi = 0;
#pragma unroll
                    for (int n = 0; n < 32; ++n) { const bool tk = v[n] > best; best = tk ? v[n] : best; bi = tk ? n : bi; }
                    tv[k] = best; e4[k] = bi;
#pragma unroll
                    for (int n = 0; n < 32; ++n) v[n] = (n == bi) ? -INFINITY : v[n]; }
                float den = 0.f;
#pragma unroll
                for (int k = 0; k < 4; ++k) { g4[k] = __expf(tv[k] - tv[0]); den += g4[k]; }
                const float inv = 1.f / den;
#pragma unroll
                for (int k = 0; k < 4; ++k) { g4[k] *= inv; rk[k] = atomicAdd((int*)&lcnt[e4[k]], 1); }
            }
            __syncthreads();
            if (F.tid < 32) { const int c = lcnt[F.tid]; lcnt[32 + F.tid] = c > 0 ? (int)atomicAdd((unsigned*)(p.ws + WS_CTL + CTL_CNT) + F.tid, (unsigned)c) : 0; }
            __syncthreads();
            LAS int* ldest = lcnt + 64;
            if (F.tid < 64) { const int grow = tile * 64 + F.tid;
                int* eidx = (int*)(p.ws + WS_EIDX) + grow * 4; int* slot = (int*)(p.ws + WS_SLOT) + grow * 4; float* gate = (float*)(p.ws + WS_GATE) + grow * 4;
#pragma unroll
                for (int k = 0; k < 4; ++k) { const int sl = lcnt[32 + e4[k]] + rk[k]; eidx[k] = e4[k]; slot[k] = sl; gate[k] = g4[k]; ldest[F.tid * 4 + k] = e4[k] * XCAP + sl; } }
            __syncthreads();
            { const unsigned char* x8 = (const unsigned char*)XBv; unsigned char* xs = p.ws + WS_XS; float* rsp = (float*)(p.ws + WS_RSP);
                u32x4 rv[8]; float rsv[8];
#pragma unroll
                for (int i = 0; i < 8; ++i) { const int grow = tile * 64 + F.wave * 8 + i; rv[i] = *((const u32x4*)(x8 + (size_t)grow * D) + F.lane); rsv[i] = RSTD[grow]; }
#pragma unroll
                for (int i = 0; i < 8; ++i)
#pragma unroll
                    for (int k = 0; k < 4; ++k) { const int dest = ldest[(F.wave * 8 + i) * 4 + k];
                        *((u32x4*)(xs + (size_t)dest * D) + F.lane) = rv[i]; if (F.lane == 0) rsp[dest] = rsv[i]; } }
        }
    }
}

using pg8::Unit;
constexpr size_t PANEL = (size_t)256 * D * 2;
struct SchedInKV {
    unsigned A0, B0, A1, B1; int G, c;
    DI bool next(int i, Unit& u) const {
        const int L = i * G + c; if (L >= 704) return false;
        if (L < 640) { const int x = L & 7, o = L >> 3; u.pm = x * 8 + (o & 7); u.pn = o >> 3; u.e = 0; }
        else { const int j = L - 640; u.pm = j & 7; u.pn = j >> 3; u.e = 1; }
        u.ar = u.pm * 256;
        return true; }
    DI unsigned aptr(const Unit& u) const { return (u.e ? A1 : A0) + (unsigned)u.pm * (unsigned)PANEL; }
    DI unsigned bptr(const Unit& u) const { return (u.e ? B1 : B0) + (unsigned)u.pn * (unsigned)PANEL; }
};
struct SchedPlain {
    unsigned A, B, panel; int G, c, nN;
    DI bool next(int i, Unit& u) const {
        const int L = i * G + c; if (L >= 64 * nN) return false;
        const int x = L & 7, o = L >> 3; u.pm = x * 8 + (o & 7); u.pn = o >> 3; u.e = 0; u.ar = u.pm * 256; return true; }
    DI unsigned aptr(const Unit& u) const { return A + (unsigned)u.pm * panel; }
    DI unsigned bptr(const Unit& u) const { return B + (unsigned)u.pn * panel; }
};
struct SchedMoE {
    unsigned A, B, bstride, panel; const LAS int* tile_e; const LAS int* pstart; int MT, G, vcu, nN; bool sparseA;
    DI bool next(int i, Unit& u) const {
        const int L = i * G + vcu, chunk = L >> 5, j = L & 31;
        int mt, pn; if (nN == 8) { mt = chunk * 4 + (j & 3); pn = j >> 2; } else { mt = chunk * 8 + (j & 7); pn = j >> 3; }
        if (mt >= MT) return false;
        u.pm = mt; u.pn = pn; u.e = tile_e[mt]; u.ar = sparseA ? u.e * XCAP + (mt * 256 - pstart[u.e]) : mt * 256; return true; }
    DI unsigned aptr(const Unit& u) const { return A + (unsigned)u.ar * (panel >> 8); }
    DI unsigned bptr(const Unit& u) const { return B + (unsigned)u.e * bstride + (unsigned)u.pn * panel; }
};

typedef f32x4 AccT[2][2][4][2];
struct EpiInKV {
    static constexpr bool PERM = true;
    bf16_t* proj; const float* rstd1; bf16_t* kx; bf16_t* vT; const float* rstdm;
    DI void operator()(const AccT& acc, const Unit& u, int wr, int wc, int fr, int fq) const {
        const int row0 = u.pm * 256 + wr * 64 + fr;
        if (u.e == 0 || u.pn < 4) {
            bf16_t* base = u.e == 0 ? proj : kx; const int ldc = u.e == 0 ? NPROJ : D; const float* rs_ = u.e == 0 ? rstd1 : rstdm;
            const int col0 = u.pn * 256 + wc * 32 + 8 * fq;
#pragma unroll
            for (int ai = 0; ai < 2; ++ai)
#pragma unroll
                for (int m = 0; m < 4; ++m) { const int row = row0 + ai * 128 + m * 16; const float rs = rs_[row]; bf16_t* rowp = base + (size_t)row * ldc + col0;
#pragma unroll
                    for (int bj = 0; bj < 2; ++bj) { const f32x4 v0 = acc[ai][bj][m][0] * rs, v1 = acc[ai][bj][m][1] * rs;
                        u32x4 w; w.x = pk2(v0[0], v0[1]); w.y = pk2(v0[2], v0[3]); w.z = pk2(v1[0], v1[1]); w.w = pk2(v1[2], v1[3]);
                        *(u32x4*)(rowp + bj * 128) = w; } }
        } else {
            const int d0 = (u.pn - 4) * 256 + wc * 32 + 8 * fq;
#pragma unroll
            for (int ai = 0; ai < 2; ++ai)
#pragma unroll
                for (int m = 0; m < 4; ++m) { const int row = row0 + ai * 128 + m * 16; const float rs = rstdm[row]; const int b = row >> 8, key = row & 255;
#pragma unroll
                    for (int bj = 0; bj < 2; ++bj)
#pragma unroll
                        for (int n = 0; n < 2; ++n)
#pragma unroll
                            for (int i = 0; i < 4; ++i) { const int dc = d0 + bj * 128 + 4 * n + i;
                                vT[((size_t)(b * D + dc)) * 256 + key] = (bf16_t)(pk2(acc[ai][bj][m][n][i] * rs, 0.f) & 0xffffu); } }
        }
    }
};
struct EpiOut {
    static constexpr bool PERM = true;
    bf16_t* xb; unsigned char* x8; unsigned* ssq;
    DI void operator()(const AccT& acc, const Unit& u, int wr, int wc, int fr, int fq) const {
        const int row0 = u.pm * 256 + wr * 64 + fr, col0 = u.pn * 256 + wc * 32 + 8 * fq;
#pragma unroll
        for (int ai = 0; ai < 2; ++ai)
#pragma unroll
            for (int m = 0; m < 4; ++m) { const int row = row0 + ai * 128 + m * 16; const size_t off = (size_t)row * D + col0; float s = 0.f;
#pragma unroll
                for (int bj = 0; bj < 2; ++bj) {
                    const u32x4 xin = *(const u32x4*)(xb + off + bj * 128);
                    const f32x4 zz = (f32x4){0.f, 0.f, 0.f, 0.f};
                    const f32x4 v0 = (DBG_MIX ? acc[ai][bj][m][0] : zz) + (f32x4){bflo(xin.x), bfhi(xin.x), bflo(xin.y), bfhi(xin.y)};
                    const f32x4 v1 = (DBG_MIX ? acc[ai][bj][m][1] : zz) + (f32x4){bflo(xin.z), bfhi(xin.z), bflo(xin.w), bfhi(xin.w)};
                    *(u32x4*)(xb + off + bj * 128) = (u32x4){pk2(v0[0], v0[1]), pk2(v0[2], v0[3]), pk2(v1[0], v1[1]), pk2(v1[2], v1[3])};
                    *(u32x2*)(x8 + off + bj * 128) = (u32x2){pk4_fp8(v0[0], v0[1], v0[2], v0[3]), pk4_fp8(v1[0], v1[1], v1[2], v1[3])};
                    s += (v0[0] * v0[0] + v0[1] * v0[1]) + (v0[2] * v0[2] + v0[3] * v0[3]) + (v1[0] * v1[0] + v1[1] * v1[1]) + (v1[2] * v1[2] + v1[3] * v1[3]); }
                s += __shfl_xor(s, 16); s += __shfl_xor(s, 32);
                if (fq == 0) atomicAdd(ssq + row, (unsigned)(s * 65536.f + 0.5f)); }
    }
};
struct EpiQ {
    static constexpr bool PERM = true;
    bf16_t* q; const unsigned* ssq;
    DI void operator()(const AccT& acc, const Unit& u, int wr, int wc, int fr, int fq) const {
        const int row0 = u.pm * 256 + wr * 64 + fr, col0 = u.pn * 256 + wc * 32 + 8 * fq;
#pragma unroll
        for (int ai = 0; ai < 2; ++ai)
#pragma unroll
            for (int m = 0; m < 4; ++m) { const int row = row0 + ai * 128 + m * 16; const float rs = rsqrtf((float)ssq[row] * (1.f / (65536.f * D)) + RMS_EPS) * (1.f / W8_SCALE); bf16_t* rowp = q + (size_t)row * D + col0;
#pragma unroll
                for (int bj = 0; bj < 2; ++bj) { const f32x4 v0 = acc[ai][bj][m][0] * rs, v1 = acc[ai][bj][m][1] * rs;
                    u32x4 w; w.x = pk2(v0[0], v0[1]); w.y = pk2(v0[2], v0[3]); w.z = pk2(v1[0], v1[1]); w.w = pk2(v1[2], v1[3]);
                    *(u32x4*)(rowp + bj * 128) = w; } }
    }
};
struct EpiWo {
    static constexpr bool PERM = true;
    bf16_t* xb;
    DI void operator()(const AccT& acc, const Unit& u, int wr, int wc, int fr, int fq) const {
        const int row0 = u.pm * 256 + wr * 64 + fr, col0 = u.pn * 256 + wc * 32 + 8 * fq;
        const float sc = 1.f / (W8_SCALE * AO8_SCALE);
#pragma unroll
        for (int ai = 0; ai < 2; ++ai)
#pragma unroll
            for (int m = 0; m < 4; ++m) { bf16_t* rowp = xb + (size_t)(row0 + ai * 128 + m * 16) * D + col0;
#pragma unroll
                for (int bj = 0; bj < 2; ++bj) { u32x4* pp = (u32x4*)(rowp + bj * 128); const u32x4 xin = *pp;
                    if (DBG_ATT) { const f32x4 v0 = acc[ai][bj][m][0] * sc + (f32x4){bflo(xin.x), bfhi(xin.x), bflo(xin.y), bfhi(xin.y)}, v1 = acc[ai][bj][m][1] * sc + (f32x4){bflo(xin.z), bfhi(xin.z), bflo(xin.w), bfhi(xin.w)};
                        *pp = (u32x4){pk2(v0[0], v0[1]), pk2(v0[2], v0[3]), pk2(v1[0], v1[1]), pk2(v1[2], v1[3])}; } } }
    }
};
struct EpiUp {
    static constexpr bool PERM = true;
    unsigned char* hid; const float* rsp; const float* b_up;
    DI void operator()(const AccT& acc, const Unit& u, int wr, int wc, int fr, int fq) const {
        const int row0 = u.pm * 256 + wr * 64 + fr, c0 = u.pn * 128 + wc * 32 + 8 * fq;
        const float* bg = b_up + (size_t)u.e * 2 * FF + c0; const float* bl = bg + FF;
        const f32x4 bg0 = *(const f32x4*)bg, bg1 = *(const f32x4*)(bg + 4), bl0 = *(const f32x4*)bl, bl1 = *(const f32x4*)(bl + 4);
        const f32x2 bgp[4] = {(f32x2){bg0[0], bg0[1]}, (f32x2){bg0[2], bg0[3]}, (f32x2){bg1[0], bg1[1]}, (f32x2){bg1[2], bg1[3]}};
        const f32x2 blp[4] = {(f32x2){bl0[0], bl0[1]}, (f32x2){bl0[2], bl0[3]}, (f32x2){bl1[0], bl1[1]}, (f32x2){bl1[2], bl1[3]}};
        const float KC = -1.702f * 1.4426950408889634f;
#pragma unroll
        for (int ai = 0; ai < 2; ++ai)
#pragma unroll
            for (int m = 0; m < 4; ++m) { const int row = row0 + ai * 128 + m * 16; const float rs = rsp[u.ar + (row - u.pm * 256)] * (1.f / W8_SCALE);
                const f32x2 rs2 = (f32x2){rs, rs};
                unsigned wds[2];
#pragma unroll
                for (int n = 0; n < 2; ++n) { f32x2 hv[2];
#pragma unroll
                    for (int hp = 0; hp < 2; ++hp) {
                        const f32x2 ga = (f32x2){acc[ai][0][m][n][2 * hp], acc[ai][0][m][n][2 * hp + 1]}, la = (f32x2){acc[ai][1][m][n][2 * hp], acc[ai][1][m][n][2 * hp + 1]};
                        f32x2 g = ga * rs2 + bgp[2 * n + hp], l = la * rs2 + blp[2 * n + hp];
                        g.x = fminf(g.x, 7.0f); g.y = fminf(g.y, 7.0f);
                        l.x = __builtin_amdgcn_fmed3f(l.x, -7.0f, 7.0f); l.y = __builtin_amdgcn_fmed3f(l.y, -7.0f, 7.0f);
                        const f32x2 ex = g * KC; f32x2 den; den.x = __builtin_amdgcn_exp2f(ex.x); den.y = __builtin_amdgcn_exp2f(ex.y);
                        den = den + 1.0f; f32x2 sg; sg.x = __builtin_amdgcn_rcpf(den.x); sg.y = __builtin_amdgcn_rcpf(den.y);
                        hv[hp] = (g * sg) * (l * H8_SCALE + H8_SCALE); }
                    wds[n] = pk4_fp8(hv[0].x, hv[0].y, hv[1].x, hv[1].y); }
                *(u32x2*)(hid + (size_t)row * FF + c0) = (u32x2){wds[0], wds[1]}; }
    }
};
struct EpiDn {
    static constexpr bool PERM = true;
    unsigned char* ys; const float* b_dn;
    DI void operator()(const AccT& acc, const Unit& u, int wr, int wc, int fr, int fq) const {
        const int row0 = u.pm * 256 + wr * 64 + fr, col0 = u.pn * 256 + wc * 32 + 8 * fq;
        const float* bb = b_dn + (size_t)u.e * D + col0;
        f32x4 bv[2][2];
#pragma unroll
        for (int bj = 0; bj < 2; ++bj) { bv[bj][0] = *(const f32x4*)(bb + bj * 128) * YS8_SCALE; bv[bj][1] = *(const f32x4*)(bb + bj * 128 + 4) * YS8_SCALE; }
        const float sc = YS8_SCALE / (W8_SCALE * H8_SCALE);
#pragma unroll
        for (int ai = 0; ai < 2; ++ai)
#pragma unroll
            for (int m = 0; m < 4; ++m) { unsigned char* rowp = ys + (size_t)(row0 + ai * 128 + m * 16) * D + col0;
#pragma unroll
                for (int bj = 0; bj < 2; ++bj) { const f32x4 v0 = acc[ai][bj][m][0] * sc + bv[bj][0], v1 = acc[ai][bj][m][1] * sc + bv[bj][1];
                    *(u32x2*)(rowp + bj * 128) = (u32x2){pk4_fp8(v0[0], v0[1], v0[2], v0[3]), pk4_fp8(v1[0], v1[1], v1[2], v1[3])}; } }
    }
};

DI void conv_tile(const Params& p, const Ctx& F, int tile) {
    const bf16_t* proj = (const bf16_t*)(p.ws + WS_PROJ); bf16_t* cat = (bf16_t*)(p.ws + WS_CAT);
    LAS bf16_t* U = (LAS bf16_t*)F.lds;
    const int b = tile >> 5, t0 = (tile & 31) * 64;
    __syncthreads();
    {
        u32x4 av[12], gv[12];
#pragma unroll
        for (int i = 0; i < 12; ++i) { const int it = F.tid + i * NTHREADS, r = it >> 6, c8 = (it & 63) * 8, t = t0 - 15 + r;
            av[i] = (u32x4){0u, 0u, 0u, 0u}; gv[i] = av[i];
            if (it < 94 * 64 && t >= 0 && t < SEQ) { const bf16_t* rowp = proj + (size_t)(b * SEQ + t) * NPROJ; av[i] = *(const u32x4*)(rowp + PGA + c8); gv[i] = *(const u32x4*)(rowp + PGG + c8); } }
#pragma unroll
        for (int i = 0; i < 12; ++i) { const int it = F.tid + i * NTHREADS, r = it >> 6, c8 = (it & 63) * 8;
            u32x4 o;
#pragma unroll
            for (int j = 0; j < 4; ++j) { const float a0 = bflo(av[i][j]), a1 = bfhi(av[i][j]), g0 = bflo(gv[i][j]), g1 = bfhi(gv[i][j]);
                o[j] = pk2(a0 * __builtin_amdgcn_rcpf(1.f + __expf(-g0)), a1 * __builtin_amdgcn_rcpf(1.f + __expf(-g1))); }
            if (it < 94 * 64) *(LAS u32x4*)(U + r * 512 + c8) = o; }
    }
    __syncthreads();
    {
        const int c = F.tid; const float* cw = p.in[9];
        float w[31];
#pragma unroll
        for (int j = 0; j < 31; ++j) w[j] = cw[j * 512 + c];
        const float bias = p.in[10][c];
        float win[31];
#pragma unroll
        for (int r = 0; r < 30; ++r) win[r] = bf1(U[r * 512 + c]);
#pragma unroll
        for (int t = 0; t < 64; ++t) {
            win[(t + 30) % 31] = bf1(U[(t + 30) * 512 + c]);
            float y = bias;
#pragma unroll
            for (int j = 0; j < 31; ++j) y += w[j] * win[(t + j) % 31];
            U[t * 512 + c] = (bf16_t)(pk2(y, 0.f) & 0xffffu);
        }
    }
    __syncthreads();
    {
        const float* lg = p.in[11]; const float* lb = p.in[12];
        const f32x4 g0 = *(const f32x4*)(lg + 8 * F.lane), g1 = *(const f32x4*)(lg + 8 * F.lane + 4), b0 = *(const f32x4*)(lb + 8 * F.lane), b1 = *(const f32x4*)(lb + 8 * F.lane + 4);
        for (int t = F.wave; t < 64; t += NWAVES) {
            const u32x4 raw = *(const LAS u32x4*)(U + t * 512 + 8 * F.lane);
            float v[8];
#pragma unroll
            for (int j = 0; j < 4; ++j) { v[2 * j] = bflo(raw[j]); v[2 * j + 1] = bfhi(raw[j]); }
            float s = 0.f;
#pragma unroll
            for (int j = 0; j < 8; ++j) s += v[j];
            const float mu = wave_sum(s) * (1.f / 512.f); float q = 0.f;
#pragma unroll
            for (int j = 0; j < 8; ++j) { v[j] -= mu; q += v[j] * v[j]; }
            const float rstd = rsqrtf(wave_sum(q) * (1.f / 512.f) + LN_EPS);
            float o[8];
#pragma unroll
            for (int j = 0; j < 8; ++j) { const float y = v[j] * rstd * (j < 4 ? g0[j & 3] : g1[j & 3]) + (j < 4 ? b0[j & 3] : b1[j & 3]); o[j] = y * __builtin_amdgcn_rcpf(1.f + __expf(-y)); }
            u32x4 w4; w4.x = pk2(o[0], o[1]); w4.y = pk2(o[2], o[3]); w4.z = pk2(o[4], o[5]); w4.w = pk2(o[6], o[7]);
            if (!DBG_CONV) w4 = (u32x4){0u, 0u, 0u, 0u};
            *(u32x4*)(cat + (size_t)(b * SEQ + t0 + t) * D + 512 + 8 * F.lane) = w4;
        }
    }
}

constexpr size_t WS_X8 = 348 * MiB;
constexpr size_t WS_X8B = 16 * MiB;
constexpr size_t WS_QT = 412 * MiB, WS_AN = 428 * MiB, WS_SB = 444 * MiB, WS_UB = 476 * MiB;
#define LBAR() do { asm volatile("s_waitcnt lgkmcnt(0)" ::: "memory"); __builtin_amdgcn_s_barrier(); asm volatile("" ::: "memory"); } while (0)
DI bf16x8 lds_frag(const LAS bf16_t* base, int row, int k) { return *(const LAS bf16x8*)(base + row * 72 + k); }
DI int gla_tok(int b, int dir, int pos) { return b * SEQ + (dir ? (SEQ - 1 - pos) : pos); }
constexpr int GLA_STG = 41984;
DI void gla_stage_a(const Params& p, const Ctx& F) {
    const bf16_t* proj = (const bf16_t*)(p.ws + WS_PROJ); const float* graw = (const float*)(p.ws + WS_GRAW);
    bf16_t* oi = (bf16_t*)(p.ws + WS_OFB); bf16_t* qtg = (bf16_t*)(p.ws + WS_QT); float* ang = (float*)(p.ws + WS_AN); bf16_t* ubg = (bf16_t*)(p.ws + WS_UB);
    LAS bf16_t* Qt = (LAS bf16_t*)(F.lds + 2 * GLA_STG);
    LAS bf16_t* Kt = Qt + 64 * 72;
    LAS bf16_t* KhT = Kt + 64 * 72;
    LAS bf16_t* P = KhT + 64 * 72;
    const int w = F.wave, lane = F.lane, fr = lane & 15, g = lane >> 4;
    __syncthreads();
    for (int i = F.tid; i < 2 * GLA_STG / 4; i += NTHREADS) ((LAS unsigned*)F.lds)[i] = 0u;
    const int hf = w >> 2, dt = w & 3;
    u32x4 Lf[2][2];
#pragma unroll
    for (int ii = 0; ii < 2; ++ii)
#pragma unroll
        for (int s2 = 0; s2 < 2; ++s2) { const int irow = 16 * (2 * hf + ii) + fr; unsigned wds[4];
#pragma unroll
            for (int t2 = 0; t2 < 4; ++t2) { const int j0 = 32 * s2 + 16 * ((2 * t2) >> 2) + 4 * g + ((2 * t2) & 3), j1 = j0 + 1;
                wds[t2] = (j0 <= irow ? 0x3F80u : 0u) | (j1 <= irow ? 0x3F800000u : 0u); }
            Lf[ii][s2] = (u32x4){wds[0], wds[1], wds[2], wds[3]}; }
    const u32x4 ones = (u32x4){0x3F803F80u, 0x3F803F80u, 0x3F803F80u, 0x3F803F80u};
    u32x4 qr, kr, vr0, vr1; f32x4 gr = (f32x4){0.f, 0.f, 0.f, 0.f};
    const int sj = F.tid >> 3, sc8 = (F.tid & 7) * 8, sc16 = (F.tid & 7) * 16, gj = F.tid >> 2, gr4 = (F.tid & 3) * 4;
#define GLA_DECODE(it_, b_, h_, d_, n_) const int b_ = (it_) >> 8, h_ = ((it_) >> 6) & 3, d_ = ((it_) >> 5) & 1, n_ = (it_) & 31
#define GLA_PREFETCH(it_) do { GLA_DECODE(it_, pb, ph, pd, pn); \
        const bf16_t* rp = proj + (size_t)gla_tok(pb, pd, pn * 64 + sj) * NPROJ; \
        qr = *(const u32x4*)(rp + PQ + ph * 64 + sc8); kr = *(const u32x4*)(rp + PK + ph * 64 + sc8); \
        vr0 = *(const u32x4*)(rp + PV + ph * 128 + sc16); vr1 = *(const u32x4*)(rp + PV + ph * 128 + sc16 + 8); \
        if (F.tid < 256) gr = *(const f32x4*)(graw + (size_t)gla_tok(pb, pd, pn * 64 + gj) * 32 + pd * 16 + gr4); } while (0)
    int item = F.vcu, cnt = 0;
    if (item < 2048) GLA_PREFETCH(item);
    bf16x8 w2f = (bf16x8){0, 0, 0, 0, 0, 0, 0, 0}; float gbias = 0.f; int w2key = -1;
    __syncthreads();
    for (; item < 2048; item += F.G, ++cnt) {
        GLA_DECODE(item, b, hh, dir, n);
        LAS unsigned char* stg = F.lds + (cnt & 1) * GLA_STG;
        LAS bf16_t* Qr = (LAS bf16_t*)stg; LAS bf16_t* Kr = Qr + 64 * 72; LAS bf16_t* vT = Kr + 64 * 72; LAS bf16_t* GF = vT + 128 * 72;
        *(LAS u32x4*)(Qr + sj * 72 + sc8) = qr; *(LAS u32x4*)(Kr + sj * 72 + sc8) = kr;
#pragma unroll
        for (int i = 0; i < 4; ++i) { vT[(sc16 + 2 * i) * 72 + sj] = (bf16_t)(vr0[i] & 0xffffu); vT[(sc16 + 2 * i + 1) * 72 + sj] = (bf16_t)(vr0[i] >> 16);
            vT[(sc16 + 8 + 2 * i) * 72 + sj] = (bf16_t)(vr1[i] & 0xffffu); vT[(sc16 + 9 + 2 * i) * 72 + sj] = (bf16_t)(vr1[i] >> 16); }
        if (F.tid < 256) { u32x2 o; o.x = pk2(gr.x, gr.y); o.y = pk2(gr.z, gr.w); *(LAS u32x2*)(GF + gj * 40 + gr4) = o; }
        if (item + F.G < 2048) GLA_PREFETCH(item + F.G);
        if (w2key != hh * 2 + dir) { w2key = hh * 2 + dir;
            const float* w2 = p.in[dir ? 6 : 4] + hh * 64 + 16 * dt + fr; float wv[8];
#pragma unroll
            for (int t2 = 0; t2 < 8; ++t2) wv[t2] = g < 2 ? w2[(8 * g + t2) * 256] : 0.f;
            w2f = __builtin_bit_cast(bf16x8, (u32x4){pk2(wv[0], wv[1]), pk2(wv[2], wv[3]), pk2(wv[4], wv[5]), pk2(wv[6], wv[7])});
            gbias = p.in[dir ? 7 : 5][hh * 64 + 16 * dt + fr]; }
        LBAR();
        {
            f32x4 la[4];
#pragma unroll
            for (int jt = 0; jt < 4; ++jt) { const bf16x8 af = *(const LAS bf16x8*)(GF + (16 * jt + fr) * 40 + 8 * g);
                la[jt] = __builtin_amdgcn_mfma_f32_16x16x32_bf16(af, w2f, (f32x4){0.f, 0.f, 0.f, 0.f}, 0, 0, 0);
#pragma unroll
                for (int r = 0; r < 4; ++r) { const float z = la[jt][r] + gbias; la[jt][r] = (fminf(z, 0.f) - __logf(1.f + __expf(-fabsf(z)))) * (1.f / 16.f); } }
            bf16x8 bhi[2], blo[2];
#pragma unroll
            for (int s2 = 0; s2 < 2; ++s2) { float hi[8], lo[8];
#pragma unroll
                for (int t2 = 0; t2 < 8; ++t2) { const float v = la[2 * s2 + (t2 >> 2)][t2 & 3]; const float hv = bflo(pk2(v, 0.f) & 0xffffu); hi[t2] = v; lo[t2] = v - hv; }
                bhi[s2] = __builtin_bit_cast(bf16x8, (u32x4){pk2(hi[0], hi[1]), pk2(hi[2], hi[3]), pk2(hi[4], hi[5]), pk2(hi[6], hi[7])});
                blo[s2] = __builtin_bit_cast(bf16x8, (u32x4){pk2(lo[0], lo[1]), pk2(lo[2], lo[3]), pk2(lo[4], lo[5]), pk2(lo[6], lo[7])}); }
            f32x4 tot = (f32x4){0.f, 0.f, 0.f, 0.f};
#pragma unroll
            for (int s2 = 0; s2 < 2; ++s2) { tot = __builtin_amdgcn_mfma_f32_16x16x32_bf16(__builtin_bit_cast(bf16x8, ones), bhi[s2], tot, 0, 0, 0);
                tot = __builtin_amdgcn_mfma_f32_16x16x32_bf16(__builtin_bit_cast(bf16x8, ones), blo[s2], tot, 0, 0, 0); }
            const float av = __expf(tot[0]);
            const int dcol = 16 * dt + fr;
#pragma unroll
            for (int ii = 0; ii < 2; ++ii) { const int it = 2 * hf + ii;
                f32x4 bc = (f32x4){0.f, 0.f, 0.f, 0.f};
#pragma unroll
                for (int s2 = 0; s2 < 2; ++s2) { bc = __builtin_amdgcn_mfma_f32_16x16x32_bf16(__builtin_bit_cast(bf16x8, Lf[ii][s2]), bhi[s2], bc, 0, 0, 0);
                    bc = __builtin_amdgcn_mfma_f32_16x16x32_bf16(__builtin_bit_cast(bf16x8, Lf[ii][s2]), blo[s2], bc, 0, 0, 0); }
                float kh[4];
#pragma unroll
                for (int r = 0; r < 4; ++r) { const int irow = 16 * it + 4 * g + r; const float e = __expf(bc[r]);
                    const float qv = bf1(Qr[irow * 72 + dcol]), kv = bf1(Kr[irow * 72 + dcol]);
                    const float kt = kv * __builtin_amdgcn_rcpf(e);
                    Qt[irow * 72 + dcol] = (bf16_t)(pk2(qv * 0.125f * e, 0.f) & 0xffffu); Kt[irow * 72 + dcol] = (bf16_t)(pk2(kt, 0.f) & 0xffffu); kh[r] = kt * av; }
                *(LAS u32x2*)(KhT + dcol * 72 + 16 * it + 4 * g) = (u32x2){pk2(kh[0], kh[1]), pk2(kh[2], kh[3])}; }
            if (hf == 0 && g == 0) ang[(size_t)item * 64 + dcol] = av;
        }
        LBAR();
        {
            const int it = w & 3;
            const bf16x8 a0 = lds_frag(Qt, 16 * it + fr, 8 * g), a1 = lds_frag(Qt, 16 * it + fr, 32 + 8 * g);
#pragma unroll
            for (int jj = 0; jj < 2; ++jj) { const int jt = 2 * (w >> 2) + jj;
                f32x4 sc = (f32x4){0.f, 0.f, 0.f, 0.f};
                sc = __builtin_amdgcn_mfma_f32_16x16x32_bf16(a0, lds_frag(Kt, 16 * jt + fr, 8 * g), sc, 0, 0, 0);
                sc = __builtin_amdgcn_mfma_f32_16x16x32_bf16(a1, lds_frag(Kt, 16 * jt + fr, 32 + 8 * g), sc, 0, 0, 0);
                const int jcol = 16 * jt + fr;
#pragma unroll
                for (int r = 0; r < 4; ++r) { const int irow = 16 * it + 4 * g + r; const bool keep = dir ? (irow > jcol) : (irow >= jcol);
                    P[irow * 72 + jcol] = (bf16_t)(pk2(keep ? sc[r] : 0.f, 0.f) & 0xffffu); } }
            *(u32x4*)(qtg + (size_t)item * 4096 + sj * 64 + sc8) = *(const LAS u32x4*)(Qt + sj * 72 + sc8);
        }
        LBAR();
        {
            const int xt = w & 3, ch = w >> 2;
            const bf16x8 p0 = lds_frag(P, 16 * xt + fr, 8 * g), p1 = lds_frag(P, 16 * xt + fr, 32 + 8 * g);
            const bf16x8 k0 = lds_frag(KhT, 16 * xt + fr, 8 * g), k1 = lds_frag(KhT, 16 * xt + fr, 32 + 8 * g);
            bf16_t* orow = oi + (size_t)dir * T * 512 + (size_t)gla_tok(b, dir, n * 64 + 16 * xt + fr) * 512 + hh * 128 + 4 * g;
            bf16_t* urow = ubg + (size_t)item * 8192 + fr * 64 + 16 * xt + 4 * g;
#pragma unroll
            for (int cc = 0; cc < 4; ++cc) { const int ct = 4 * ch + cc;
                const bf16x8 v0 = lds_frag(vT, 16 * ct + fr, 8 * g), v1 = lds_frag(vT, 16 * ct + fr, 32 + 8 * g);
                f32x4 o = (f32x4){0.f, 0.f, 0.f, 0.f}, u = (f32x4){0.f, 0.f, 0.f, 0.f};
                o = __builtin_amdgcn_mfma_f32_16x16x32_bf16(v0, p0, o, 0, 0, 0); o = __builtin_amdgcn_mfma_f32_16x16x32_bf16(v1, p1, o, 0, 0, 0);
                u = __builtin_amdgcn_mfma_f32_16x16x32_bf16(k0, v0, u, 0, 0, 0); u = __builtin_amdgcn_mfma_f32_16x16x32_bf16(k1, v1, u, 0, 0, 0);
                *(u32x2*)(orow + 16 * ct) = (u32x2){pk2(o[0], o[1]), pk2(o[2], o[3])};
                *(u32x2*)(urow + (size_t)(16 * ct) * 64) = (u32x2){pk2(u[0], u[1]), pk2(u[2], u[3])}; }
        }
    }
#undef GLA_PREFETCH
#undef GLA_DECODE
}

DI void gla_stage_b(const Params& p, const Ctx& F) {
    const bf16_t* ubg = (const bf16_t*)(p.ws + WS_UB); const float* ang = (const float*)(p.ws + WS_AN); bf16_t* sbg = (bf16_t*)(p.ws + WS_SB);
    for (int gid = F.vcu * NTHREADS + F.tid; gid < 64 * 2048; gid += F.G * NTHREADS) {
        const int seq = gid >> 11, e4 = (gid & 2047) * 4, d4 = e4 & 63;
        f32x4 S = (f32x4){0.f, 0.f, 0.f, 0.f};
#pragma unroll 8
        for (int n = 0; n < 32; ++n) { const size_t item = (size_t)seq * 32 + n;
            const u32x2 ub = *(const u32x2*)(ubg + item * 8192 + e4); const f32x4 U = (f32x4){bflo(ub.x), bfhi(ub.x), bflo(ub.y), bfhi(ub.y)}, a = *(const f32x4*)(ang + item * 64 + d4);
            *(u32x2*)(sbg + item * 8192 + e4) = (u32x2){pk2(S.x, S.y), pk2(S.z, S.w)};
            S = a * S + U; }
    }
}

DI bf16x8 swz_frag(const LAS bf16_t* base, int row, int q) { return *(const LAS bf16x8*)(base + row * 64 + ((q ^ (row & 7)) << 3)); }
DI void gla_stage_c(const Params& p, const Ctx& F, int tile) {
    const bf16_t* proj = (const bf16_t*)(p.ws + WS_PROJ); const bf16_t* oi = (const bf16_t*)(p.ws + WS_OFB);
    const bf16_t* qtg = (const bf16_t*)(p.ws + WS_QT); const bf16_t* sbg = (const bf16_t*)(p.ws + WS_SB); bf16_t* cat = (bf16_t*)(p.ws + WS_CAT);
    LAS bf16_t* SL = (LAS bf16_t*)F.lds;
    LAS bf16_t* QL = SL + 4 * 8192;
    LAS float* part = (LAS float*)(F.lds + 98304);
    const int b = tile >> 5, n = tile & 31, w = F.wave, fr = F.lane & 15, g = F.lane >> 4, xt = w & 3, ch = w >> 2;
    const int tl = 16 * xt + fr, tok = b * SEQ + n * 64 + tl;
    f32x4 acc[4][4];
    __syncthreads();
#pragma unroll
    for (int rd = 0; rd < 2; ++rd) {
        u32x4 sv[8], qv[4];
#pragma unroll
        for (int i = 0; i < 8; ++i) { const int idx = F.tid + i * NTHREADS, cb = idx >> 10, ck = idx & 1023; const int hh = 2 * rd + (cb >> 1), dir = cb & 1;
            const size_t item = (size_t)(((b * 4 + hh) * 2 + dir) * 32 + (dir ? 31 - n : n));
            sv[i] = *(const u32x4*)(sbg + item * 8192 + ck * 8); }
#pragma unroll
        for (int i = 0; i < 4; ++i) { const int idx = F.tid + i * NTHREADS, cb = idx >> 9, ck = idx & 511; const int hh = 2 * rd + (cb >> 1), dir = cb & 1;
            const size_t item = (size_t)(((b * 4 + hh) * 2 + dir) * 32 + (dir ? 31 - n : n));
            qv[i] = *(const u32x4*)(qtg + item * 4096 + ck * 8); }
#pragma unroll
        for (int h2 = 0; h2 < 2; ++h2) { const int hh = 2 * rd + h2;
#pragma unroll
            for (int cc = 0; cc < 4; ++cc) { const size_t off = (size_t)tok * 512 + hh * 128 + 16 * (4 * ch + cc) + 4 * g;
                const u32x2 f = *(const u32x2*)(oi + off), bk = *(const u32x2*)(oi + (size_t)T * 512 + off);
                acc[hh][cc] = (f32x4){bflo(f.x) + bflo(bk.x), bfhi(f.x) + bfhi(bk.x), bflo(f.y) + bflo(bk.y), bfhi(f.y) + bfhi(bk.y)}; } }
        if (rd) __syncthreads();
#pragma unroll
        for (int i = 0; i < 8; ++i) { const int idx = F.tid + i * NTHREADS, cb = idx >> 10, ck = idx & 1023, r = ck >> 3, q = ck & 7;
            *(LAS u32x4*)(SL + cb * 8192 + r * 64 + ((q ^ (r & 7)) << 3)) = sv[i]; }
#pragma unroll
        for (int i = 0; i < 4; ++i) { const int idx = F.tid + i * NTHREADS, cb = idx >> 9, ck = idx & 511, r = ck >> 3, q = ck & 7;
            *(LAS u32x4*)(QL + cb * 4096 + r * 64 + ((q ^ (r & 7)) << 3)) = qv[i]; }
        __syncthreads();
#pragma unroll
        for (int h2 = 0; h2 < 2; ++h2) { const int hh = 2 * rd + h2;
#pragma unroll
            for (int dir = 0; dir < 2; ++dir) { const int cb = 2 * h2 + dir;
                const int qrow = dir ? 63 - tl : tl;
                const bf16x8 q0 = swz_frag(QL + cb * 4096, qrow, g), q1 = swz_frag(QL + cb * 4096, qrow, 4 + g);
#pragma unroll
                for (int cc = 0; cc < 4; ++cc) { const int crow = 16 * (4 * ch + cc) + fr;
                    acc[hh][cc] = __builtin_amdgcn_mfma_f32_16x16x32_bf16(swz_frag(SL + cb * 8192, crow, g), q0, acc[hh][cc], 0, 0, 0);
                    acc[hh][cc] = __builtin_amdgcn_mfma_f32_16x16x32_bf16(swz_frag(SL + cb * 8192, crow, 4 + g), q1, acc[hh][cc], 0, 0, 0); } }
            float s = 0.f;
#pragma unroll
            for (int cc = 0; cc < 4; ++cc) s += (acc[hh][cc][0] * acc[hh][cc][0] + acc[hh][cc][1] * acc[hh][cc][1]) + (acc[hh][cc][2] * acc[hh][cc][2] + acc[hh][cc][3] * acc[hh][cc][3]);
            s += __shfl_xor(s, 16); s += __shfl_xor(s, 32);
            if (g == 0) part[(hh * 2 + ch) * 64 + tl] = s; }
    }
    __syncthreads();
#pragma unroll
    for (int hh = 0; hh < 4; ++hh) {
        const float rstd = rsqrtf((part[(hh * 2) * 64 + tl] + part[(hh * 2 + 1) * 64 + tl]) * (1.f / 128.f) + RMS_EPS);
#pragma unroll
        for (int cc = 0; cc < 4; ++cc) { const int c = 16 * (4 * ch + cc) + 4 * g;
            const f32x4 ng = *(const f32x4*)(p.in[8] + c);
            const u32x2 rr = *(const u32x2*)(proj + (size_t)tok * NPROJ + PR + hh * 128 + c);
            const float r0 = bflo(rr.x), r1 = bfhi(rr.x), r2 = bflo(rr.y), r3 = bfhi(rr.y);
            const float o0 = acc[hh][cc][0] * rstd * ng[0] * (r0 * __builtin_amdgcn_rcpf(1.f + __expf(-r0))), o1 = acc[hh][cc][1] * rstd * ng[1] * (r1 * __builtin_amdgcn_rcpf(1.f + __expf(-r1)));
            const float o2 = acc[hh][cc][2] * rstd * ng[2] * (r2 * __builtin_amdgcn_rcpf(1.f + __expf(-r2))), o3 = acc[hh][cc][3] * rstd * ng[3] * (r3 * __builtin_amdgcn_rcpf(1.f + __expf(-r3)));
            *(u32x2*)(cat + (size_t)tok * D + hh * 128 + c) = (u32x2){pk2(o0, o1), pk2(o2, o3)}; }
    }
}

constexpr int ATT_PITCH = 264;
DI void attn_load_tile(const Ctx& F, LAS bf16_t* dst, const __amdgpu_buffer_rsrc_t rsrc, unsigned src_off, int src_pitch_bytes) {
    const int r0 = F.tid >> 5, c8 = (F.tid & 31) * 8; const unsigned voff = (unsigned)(r0 * src_pitch_bytes + c8 * 2);
    u32x4 v[16];
#pragma unroll
    for (int i = 0; i < 16; ++i) v[i] = __builtin_amdgcn_raw_buffer_load_b128(rsrc, voff, src_off + (unsigned)(16 * i * src_pitch_bytes), 0);
#pragma unroll
    for (int i = 0; i < 16; ++i) *(LAS u32x4*)(dst + (r0 + 16 * i) * ATT_PITCH + c8) = v[i];
}
DI void attn_unit(const Params& p, const Ctx& F, int unit) {
    const int b = unit >> 5, hd = (unit >> 3) & 3, qt = unit & 7;
    const bf16_t* q = (const bf16_t*)(p.ws + WS_Q); const bf16_t* kx = (const bf16_t*)(p.ws + WS_KX); const bf16_t* vT = (const bf16_t*)(p.ws + WS_VT);
    unsigned char* ao = p.ws + WS_AO;
    LAS bf16_t* Ts = (LAS bf16_t*)F.lds;
    const int l31 = F.lane & 31, h = F.lane >> 5;
    const int tok = b * SEQ + qt * 256 + F.wave * 32 + l31;
    __syncthreads();
    const __amdgpu_buffer_rsrc_t rsrc = __builtin_amdgcn_make_buffer_rsrc((void*)p.ws, 0, 0x7fffffff, 0x00020000);
    attn_load_tile(F, Ts, rsrc, (unsigned)(WS_KX + ((size_t)(b * MEMLEN) * D + hd * 256) * 2), D * 2);
    bf16x8 Bq[16];
#pragma unroll
    for (int s = 0; s < 16; ++s) Bq[s] = *(const bf16x8*)(q + (size_t)tok * D + hd * 256 + 16 * s + 8 * h);
    __syncthreads();
    f32x16 sacc[8];
#pragma unroll
    for (int kt = 0; kt < 8; ++kt) {
#pragma unroll
        for (int s = 0; s < 16; ++s) { const bf16x8 a = *(const LAS bf16x8*)(Ts + (32 * kt + l31) * ATT_PITCH + 16 * s + 8 * h);
            sacc[kt] = __builtin_amdgcn_mfma_f32_32x32x16_bf16(a, Bq[s], s == 0 ? ZERO16 : sacc[kt], 0, 0, 0); }
    }
    float mx = -INFINITY;
#pragma unroll
    for (int kt = 0; kt < 8; ++kt)
#pragma unroll
        for (int i = 0; i < 16; ++i) mx = fmaxf(mx, sacc[kt][i]);
    mx = fmaxf(mx, __shfl_xor(mx, 32));
    const float sc = 0.0625f * 1.4426950408889634f; float sum = 0.f;
#pragma unroll
    for (int kt = 0; kt < 8; ++kt)
#pragma unroll
        for (int i = 0; i < 16; ++i) { const float e = __builtin_amdgcn_exp2f((sacc[kt][i] - mx) * sc); sacc[kt][i] = e; sum += e; }
    sum += __shfl_xor(sum, 32);
    const float inv = 1.f / sum;
    bf16x8 Pf[8][2];
#pragma unroll
    for (int kt = 0; kt < 8; ++kt)
#pragma unroll
        for (int s2 = 0; s2 < 2; ++s2) { u32x4 w;
            w.x = pk2(sacc[kt][8 * s2 + 0] * inv, sacc[kt][8 * s2 + 1] * inv); w.y = pk2(sacc[kt][8 * s2 + 2] * inv, sacc[kt][8 * s2 + 3] * inv);
            w.z = pk2(sacc[kt][8 * s2 + 4] * inv, sacc[kt][8 * s2 + 5] * inv); w.w = pk2(sacc[kt][8 * s2 + 6] * inv, sacc[kt][8 * s2 + 7] * inv);
            Pf[kt][s2] = __builtin_bit_cast(bf16x8, w); }
    __syncthreads();
    attn_load_tile(F, Ts, rsrc, (unsigned)(WS_VT + ((size_t)(b * D + hd * 256) * 256) * 2), 256 * 2);
    __syncthreads();
#pragma unroll 1
    for (int dt = 0; dt < 8; ++dt) {
        f32x16 oacc;
#pragma unroll
        for (int kt = 0; kt < 8; ++kt)
#pragma unroll
            for (int s2 = 0; s2 < 2; ++s2) { const LAS bf16_t* vp = Ts + (32 * dt + l31) * ATT_PITCH + 32 * kt + 16 * s2 + 4 * h;
                const u32x2 lo = *(const LAS u32x2*)vp, hi = *(const LAS u32x2*)(vp + 8);
                const bf16x8 a = __builtin_bit_cast(bf16x8, (u32x4){lo.x, lo.y, hi.x, hi.y});
                oacc = __builtin_amdgcn_mfma_f32_32x32x16_bf16(a, Pf[kt][s2], (kt == 0 && s2 == 0) ? ZERO16 : oacc, 0, 0, 0); }
        unsigned char* op = ao + (size_t)tok * D + hd * 256 + 32 * dt + 4 * h;
#pragma unroll
        for (int g = 0; g < 4; ++g) *(unsigned*)(op + 8 * g) = pk4_fp8(oacc[4 * g] * AO8_SCALE, oacc[4 * g + 1] * AO8_SCALE, oacc[4 * g + 2] * AO8_SCALE, oacc[4 * g + 3] * AO8_SCALE);
    }
}

DI void moe_tables(const Params& p, const Ctx& F) {
    LAS int* misc = (LAS int*)(F.lds + MISC_OFF);
    __syncthreads();
    if (F.tid < NE) misc[400 + F.tid] = (int)__hip_atomic_load((const unsigned*)(p.ws + WS_CTL + CTL_CNT) + F.tid, __ATOMIC_RELAXED, __HIP_MEMORY_SCOPE_AGENT);
    __syncthreads();
    if (F.tid == 0) {
        int row = 0, mt = 0;
        for (int e = 0; e < NE; ++e) { const int c = misc[400 + e]; const int nt = (c + 255) >> 8;
            misc[32 + e] = row; for (int i = 0; i < nt; ++i) misc[96 + mt + i] = e; mt += nt; row += nt * 256; }
        misc[32 + NE] = row; misc[16] = mt;
    }
    __syncthreads();
}
DI f32x2 fp8x2_lo(unsigned w) { return __builtin_amdgcn_cvt_pk_f32_fp8((int)w, false); }
DI f32x2 fp8x2_hi(unsigned w) { return __builtin_amdgcn_cvt_pk_f32_fp8((int)w, true); }
DI void p12_final(const Params& p, const Ctx& F) {
    const int gw = F.vcu * NWAVES + F.wave, NGW = F.G * NWAVES;
    const unsigned char* ys = p.ws + WS_YS; const int* eidx = (const int*)(p.ws + WS_EIDX); const int* slot = (const int*)(p.ws + WS_SLOT); const float* gate = (const float*)(p.ws + WS_GATE);
    const LAS int* misc = (const LAS int*)(F.lds + MISC_OFF);
    f32x4 fgv[4];
#pragma unroll
    for (int j = 0; j < 4; ++j) fgv[j] = *(const f32x4*)(p.in[27] + 4 * (64 * j + F.lane));
    for (int t0 = gw; t0 < T; t0 += 8 * NGW) {
        int destv = 0; float gatev = 0.f;
        { const int q = (F.lane >> 2) & 7, k = F.lane & 3; int tq = t0 + q * NGW; if (tq >= T) tq = t0;
          const int e = eidx[tq * 4 + k]; destv = misc[32 + e] + slot[tq * 4 + k]; gatev = gate[tq * 4 + k] * (1.f / YS8_SCALE); }
#pragma unroll
        for (int pr = 0; pr < 2; ++pr) {
            u32x2 xx[4][4]; unsigned yy[4][4][4]; int tt[4];
#pragma unroll
            for (int q4 = 0; q4 < 4; ++q4) { const int q = 4 * pr + q4; tt[q4] = t0 + q * NGW; if (tt[q4] >= T) tt[q4] = t0;
                const u32x2* x2r = (const u32x2*)((const bf16_t*)(p.ws + WS_AB) + (size_t)tt[q4] * D);
#pragma unroll
                for (int j = 0; j < 4; ++j) xx[q4][j] = x2r[64 * j + F.lane];
#pragma unroll
                for (int k = 0; k < (DBG_MOE ? 4 : 0); ++k) { const int dest = __builtin_amdgcn_readlane(destv, 4 * q + k); const unsigned* yr = (const unsigned*)(ys + (size_t)dest * D);
#pragma unroll
                    for (int j = 0; j < 4; ++j) yy[q4][k][j] = yr[64 * j + F.lane]; } }
#pragma unroll
            for (int q4 = 0; q4 < 4; ++q4) { const int q = 4 * pr + q4; f32x4 v[4];
#pragma unroll
                for (int j = 0; j < 4; ++j) v[j] = (f32x4){bflo(xx[q4][j].x), bfhi(xx[q4][j].x), bflo(xx[q4][j].y), bfhi(xx[q4][j].y)};
#pragma unroll
                for (int k = 0; k < (DBG_MOE ? 4 : 0); ++k) { const float g = __builtin_bit_cast(float, __builtin_amdgcn_readlane(__builtin_bit_cast(int, gatev), 4 * q + k));
#pragma unroll
                    for (int j = 0; j < 4; ++j) { const f32x2 a = fp8x2_lo(yy[q4][k][j]), c = fp8x2_hi(yy[q4][k][j]);
                        v[j].x += g * a.x; v[j].y += g * a.y; v[j].z += g * c.x; v[j].w += g * c.y; } }
                float s2 = 0.f;
#pragma unroll
                for (int j = 0; j < 4; ++j) s2 += (v[j].x * v[j].x + v[j].y * v[j].y) + (v[j].z * v[j].z + v[j].w * v[j].w);
                const float rstd = rsqrtf(wave_sum(s2) * (1.f / D) + RMS_EPS);
                if (t0 + q * NGW < T) { f32x4* xr = (f32x4*)(p.out + (size_t)tt[q4] * D);
#pragma unroll
                    for (int j = 0; j < 4; ++j) xr[64 * j + F.lane] = v[j] * rstd * fgv[j]; } }
        }
    }
}

constexpr int NPHASES = 12;
__global__ void __launch_bounds__(NTHREADS, 2) enc_fwd(Params p) {
    extern __shared__ __attribute__((aligned(16))) unsigned char lds_raw[];
    Ctx F; F.lds = (LAS unsigned char*)lds_raw;
    F.tid = threadIdx.x; F.lane = F.tid & 63; F.wave = __builtin_amdgcn_readfirstlane(F.tid >> 6);
    F.G = gridDim.x; { const int bx = blockIdx.x; F.vcu = (F.G % 8 == 0) ? (bx % 8) * (F.G / 8) + bx / 8 : bx; }
    volatile LAS unsigned* MISC = (volatile LAS unsigned*)(F.lds + MISC_OFF);
    if (F.tid < 4) MISC[F.tid] = 0u;
    __syncthreads();
    const int lo = p.ph_lo, hi = p.ph_hi;
    XcdBarrier bar; bar.bar = (unsigned*)(p.ws + WS_CTL + CTL_BAR); bar.x = 0; bar.st = MISC;
    if (hi - lo > 1) bar = xcd_barrier_post((unsigned*)(p.ws + WS_CTL + CTL_BAR), MISC);
#define IN(k) (lo <= (k) && (k) < hi)
#define SEAM(k) do { if (IN(k) && IN((k) + 1)) xcd_barrier(bar); } while (0)
    unsigned char* ws = p.ws;
    const int cidx = (int)blockIdx.x;

    if (IN(0)) for (int rep = 0; rep < NREP(0); ++rep) {
        if (blockIdx.x & 1) { p0_weights(p, F); p0_mem(p, F); __syncthreads(); skinny_phase<0>(p, F, p.in[0], p.in[3] + 1536, INW, p.in[2], (bf16_t*)(ws + WS_AB), (float*)(ws + WS_RSTD1)); }
        else { skinny_phase<0>(p, F, p.in[0], p.in[3] + 1536, INW, p.in[2], (bf16_t*)(ws + WS_AB), (float*)(ws + WS_RSTD1)); __syncthreads(); p0_mem(p, F); p0_weights(p, F); }
    }
    SEAM(0);
    if (IN(1)) {
        SchedInKV S{(unsigned)WS_AB, (unsigned)WS_WIN, (unsigned)WS_MEMB, (unsigned)WS_WKV, F.G, cidx};
        EpiInKV E{(bf16_t*)(ws + WS_PROJ), (const float*)(ws + WS_RSTD1), (bf16_t*)(ws + WS_KX), (bf16_t*)(ws + WS_VT), (const float*)(ws + WS_RSTDM)};
        pg8::gemm_phase<EpiInKV, SchedInKV>(F.lds, ws, 2 * D, S, E);
    }
    SEAM(1);
    if (IN(2)) for (int rep = 0; rep < NREP(2); ++rep) gla_stage_a(p, F);
    SEAM(2);
    if (IN(3)) for (int rep = 0; rep < NREP(3); ++rep) {
        gla_stage_b(p, F);
        for (int tile = F.vcu; tile < T / 64; tile += F.G) conv_tile(p, F, tile);
    }
    SEAM(3);
    if (IN(4)) for (int rep = 0; rep < NREP(4); ++rep) { for (int tile = F.vcu; tile < T / 64; tile += F.G) gla_stage_c(p, F, tile); }
    SEAM(4);
    if (IN(5)) {
        SchedPlain S{(unsigned)WS_CAT, (unsigned)WS_WOUT, (unsigned)PANEL, F.G, cidx, 4};
        EpiOut E{(bf16_t*)(ws + WS_AB), ws + WS_X8, (unsigned*)(ws + WS_CTL + CTL_SSQ2)};
        pg8::gemm_phase<EpiOut, SchedPlain>(F.lds, ws, 2 * D, S, E);
    }
    SEAM(5);
    if (IN(6)) {
        SchedPlain S{(unsigned)WS_X8, (unsigned)WS_WQ, (unsigned)(256 * D), F.G, cidx, 4};
        EpiQ E{(bf16_t*)(ws + WS_Q), (const unsigned*)(ws + WS_CTL + CTL_SSQ2)};
        pg8::gemm_phase<EpiQ, SchedPlain, true>(F.lds, ws, D, S, E);
        pg8::Unit u;
        for (int i = 0; S.next(i, u); ++i) attn_unit(p, F, ((u.pm >> 3) << 5) | (u.pn << 3) | (u.pm & 7));
    }
    SEAM(6);
    if (IN(7)) {
        SchedPlain S{(unsigned)WS_AO, (unsigned)WS_WO, (unsigned)(256 * D), F.G, cidx, 4};
        EpiWo E{(bf16_t*)(ws + WS_AB)};
        pg8::gemm_phase<EpiWo, SchedPlain, true>(F.lds, ws, D, S, E);
    }
    SEAM(7);
    if (IN(8)) skinny_phase<1>(p, F, ws + WS_AB, p.in[21], NE, p.in[20], ws + WS_X8B, (float*)(ws + WS_RSTD3));
    SEAM(8);
    if (IN(9)) {
        moe_tables(p, F);
        const LAS int* misc = (const LAS int*)(F.lds + MISC_OFF);
        SchedMoE S{(unsigned)WS_XS, (unsigned)WS_WUP, (unsigned)(2 * FF * D), (unsigned)(256 * D), misc + 96, misc + 32, misc[16], F.G, F.vcu, 8, true};
        EpiUp E{ws + WS_HID, (const float*)(ws + WS_RSP), p.in[24]};
        pg8::gemm_phase<EpiUp, SchedMoE, true>(F.lds, ws, D, S, E);
    }
    SEAM(9);
    if (IN(10)) {
        moe_tables(p, F);
        const LAS int* misc = (const LAS int*)(F.lds + MISC_OFF);
        SchedMoE S{(unsigned)WS_HID, (unsigned)WS_WDN, (unsigned)(D * FF), (unsigned)(256 * FF), misc + 96, misc + 32, misc[16], F.G, F.vcu, 4, false};
        EpiDn E{ws + WS_YS, p.in[26]};
        pg8::gemm_phase<EpiDn, SchedMoE, true>(F.lds, ws, FF, S, E);
    }
    SEAM(10);
    if (IN(11)) { moe_tables(p, F); p12_final(p, F); }
#undef IN
#undef SEAM
}

#ifndef MK_PER_PHASE
#define MK_PER_PHASE 0
#endif
extern "C" void kernel_launch(void* const* d_in, const int* in_sizes, int n_in, void* d_out, int out_size, void* d_ws, size_t ws_size, hipStream_t stream) {
    static int grid = 0;
    if (grid == 0) {
        if (n_in != 28 || in_sizes[0] != T * D || out_size != T * D || ws_size < WS_END) {
            fprintf(stderr, "kernel_launch: built for 28 inputs, x/out of %d floats, >= %zu bytes of workspace; got n_in %d, in0 %d, out %d, ws %zu\n", T * D, (size_t)WS_END, n_in, n_in > 0 ? in_sizes[0] : -1, out_size, ws_size); grid = -1; return; }
        int dev = 0, cus = 0, per_cu = 0;
        if (hipGetDevice(&dev) != hipSuccess || hipDeviceGetAttribute(&cus, hipDeviceAttributeMultiprocessorCount, dev) != hipSuccess) { grid = -1; return; }
        if (hipFuncSetAttribute((const void*)enc_fwd, hipFuncAttributeMaxDynamicSharedMemorySize, LDS_BYTES) != hipSuccess) { fprintf(stderr, "kernel_launch: hipFuncSetAttribute(%d B LDS) failed\n", LDS_BYTES); grid = -1; return; }
        if (hipOccupancyMaxActiveBlocksPerMultiprocessor(&per_cu, (const void*)enc_fwd, NTHREADS, LDS_BYTES) != hipSuccess || per_cu < 1)
            fprintf(stderr, "kernel_launch: occupancy query reports %d workgroups per CU\n", per_cu);
        (void)hipGetLastError();
        grid = cus;
    }
    if (grid < 0) return;
    if (hipMemsetAsync((char*)d_ws + WS_CTL, 0, CTL_ZERO_BYTES, stream) != hipSuccess) return;
    Params p{};
    for (int i = 0; i < 28; ++i) p.in[i] = (const float*)d_in[i];
    p.out = (float*)d_out; p.ws = (unsigned char*)d_ws;
#if MK_PER_PHASE
    for (int ph = 0; ph < NPHASES; ++ph) { p.ph_lo = ph; p.ph_hi = ph + 1; hipLaunchKernelGGL(enc_fwd, dim3(grid), dim3(NTHREADS), LDS_BYTES, stream, p); }
#else
    p.ph_lo = 0; p.ph_hi = NPHASES; hipLaunchKernelGGL(enc_fwd, dim3(grid), dim3(NTHREADS), LDS_BYTES, stream, p);
#endif
}
```
